# Optimizing an MI355X kernel written in HIP

```python
import math
import numpy as np
import jax, jax.numpy as jnp
from jax import lax

D_MODEL = 4096
BATCH = 4
SEQ = 2048
DEPTH = 2

HEAD_DIM = 128
HG_HEADS = 8
HG_DK = 128
HG_DV = 128
LB_FLOOR = 1e-30
GD_HEADS = 8
GD_DK = 128
GD_DV = 128
CONV_W = 4
NSA_HEADS = 16
NSA_KV = 4
NSA_HPG = NSA_HEADS // NSA_KV
CMP_LEN = 32
CMP_STRIDE = 16
CMP_HIDDEN = 256
SLC_LEN = 64
SLC_TOP = 16
WINDOW = 512
WIN_BLOCK = 128
SLC_Q_CHUNK = 32
CHUNK = 64
ROPE_THETA = 10000.0
NORM_EPS = 1e-6
NEG = -1e30
FFN_HIDDEN = -(-8 * D_MODEL // (3 * 256)) * 256

HG_W = HG_HEADS * HG_DK
GD_W = GD_HEADS * GD_DK
NSA_W = NSA_HEADS * HEAD_DIM
NSA_KV_W = NSA_KV * HEAD_DIM
MIX_W = HG_W + GD_W + NSA_W
GD_CONV_C = GD_HEADS * (2 * GD_DK + GD_DV)
IN_SIZES = (HG_W, HG_W, HG_HEADS * HG_DV, HG_HEADS * HG_DV,
            GD_W, GD_W, GD_HEADS * GD_DV, GD_HEADS * GD_DV,
            GD_HEADS, GD_HEADS,
            NSA_W,
            NSA_KV_W, NSA_KV_W, NSA_KV_W, NSA_KV_W, NSA_KV_W, NSA_KV_W,
            NSA_HEADS * 3)
N_IN = sum(IN_SIZES)

kernel_name = "hymba_hgrn2_gdn_nsa_hybrid"


def _rmsnorm(x, w):
    xf = x.astype(jnp.float32)
    y = xf * lax.rsqrt(jnp.mean(xf * xf, axis=-1, keepdims=True) + NORM_EPS)
    return (y * w.astype(jnp.float32)).astype(x.dtype)


def _rope_tables(T):
    inv = ROPE_THETA ** (-jnp.arange(0, HEAD_DIM, 2, dtype=jnp.float32) / HEAD_DIM)
    ang = jnp.arange(T, dtype=jnp.float32)[:, None] * inv[None, :]
    return jnp.cos(ang), jnp.sin(ang)


def _rope(x, cos, sin):
    half = HEAD_DIM // 2
    xf = x.astype(jnp.float32)
    x1, x2 = xf[..., :half], xf[..., half:]
    c, s = cos[:, None, :], sin[:, None, :]
    return jnp.concatenate([x1 * c - x2 * s, x2 * c + x1 * s], axis=-1).astype(x.dtype)


def _chunks(a):
    B, T, H = a.shape[:3]
    a = a.reshape((B, T // CHUNK, CHUNK, H) + a.shape[3:])
    return jnp.transpose(a, (1, 0, 3, 2) + tuple(range(4, a.ndim)))


def _unchunks(a):
    nC, B, H, C, d = a.shape
    return jnp.transpose(a, (1, 0, 3, 2, 4)).reshape(B, nC * C, H, d)


def _hgrn2_step(S, inp):
    q, k, v, lf = inp
    C = q.shape[-2]
    b = jnp.cumsum(lf, axis=-2)
    causal = jnp.tril(jnp.ones((C, C), dtype=bool))
    diff = b[..., :, None, :] - b[..., None, :, :]
    dec = jnp.exp(jnp.where(causal[:, :, None], diff, -jnp.inf))
    att = jnp.einsum('bhtd,bhsd,bhtsd->bhts', q, k, dec)
    o = (jnp.einsum('bhtd,bhde->bhte', q * jnp.exp(b), S)
         + jnp.einsum('bhts,bhse->bhte', att, v))
    b_last = b[..., -1:, :]
    S = (jnp.exp(b_last[..., 0, :])[..., None] * S
         + jnp.einsum('bhsd,bhse->bhde', k * jnp.exp(b_last - b), v))
    return S, o


def _hgrn2(q, f_pre, i, g, lb, norm_w):
    B, T, _ = q.shape
    f32 = jnp.float32
    qf = jax.nn.silu(q.astype(f32)).reshape(B, T, HG_HEADS, HG_DK)
    fp = f_pre.astype(f32)
    log_lb = jnp.log(jnp.maximum(lb, LB_FLOOR))
    logf = jnp.minimum(jax.nn.log_sigmoid(fp) + jax.nn.softplus(log_lb - fp), 0.0)
    kf = -jnp.expm1(logf)
    logf = logf.reshape(B, T, HG_HEADS, HG_DK)
    kf = kf.reshape(B, T, HG_HEADS, HG_DK)
    vf = i.astype(f32).reshape(B, T, HG_HEADS, HG_DV)
    S0 = jnp.zeros((B, HG_HEADS, HG_DK, HG_DV), f32)
    _, o = lax.scan(_hgrn2_step, S0, (_chunks(qf), _chunks(kf), _chunks(vf), _chunks(logf)))
    o = _rmsnorm(_unchunks(o), norm_w)
    o = o * jax.nn.silu(g.astype(f32)).reshape(B, T, HG_HEADS, HG_DV)
    return o.reshape(B, T, HG_HEADS * HG_DV).astype(q.dtype)


def _gdn_step(S, inp):
    qd, qk, u, w, kd, dl = inp
    v_new = u - jnp.einsum('bhck,bhkv->bhcv', w, S)
    o = jnp.einsum('bhck,bhkv->bhcv', qd, S) + jnp.einsum('bhts,bhsv->bhtv', qk, v_new)
    S = dl[..., None, None] * S + jnp.einsum('bhck,bhcv->bhkv', kd, v_new)
    return S, o


def _gdn(q, k, v, z, a, b, conv_w, A_log, dt_bias, norm_w):
    B, T, _ = q.shape
    f32 = jnp.float32
    qkv = jnp.concatenate([q, k, v], axis=-1)
    qkv = lax.conv_general_dilated(qkv, conv_w[:, None, :].astype(qkv.dtype), window_strides=(1,),
                                   padding=[(CONV_W - 1, 0)],
                                   dimension_numbers=('NWC', 'WIO', 'NWC'),
                                   feature_group_count=GD_CONV_C)
    qkv = jax.nn.silu(qkv.astype(f32))
    qf, kf, vf = jnp.split(qkv, [GD_W, 2 * GD_W], axis=-1)
    qf = qf.reshape(B, T, GD_HEADS, GD_DK)
    kf = kf.reshape(B, T, GD_HEADS, GD_DK)
    vf = vf.reshape(B, T, GD_HEADS, GD_DV)
    qf = qf * lax.rsqrt(jnp.sum(qf * qf, -1, keepdims=True) + NORM_EPS) * (GD_DK ** -0.5)
    kf = kf * lax.rsqrt(jnp.sum(kf * kf, -1, keepdims=True) + NORM_EPS)
    beta = jax.nn.sigmoid(b.astype(f32))
    g = -jnp.exp(A_log.astype(f32)) * jax.nn.softplus(a.astype(f32) + dt_bias.astype(f32))
    qc, kc, vc = _chunks(qf), _chunks(kf), _chunks(vf)
    bc = _chunks(beta[..., None])[..., 0]
    gc = jnp.cumsum(_chunks(g[..., None])[..., 0], axis=-1)
    C = CHUNK
    incl = jnp.tril(jnp.ones((C, C), dtype=bool))
    strict = jnp.tril(jnp.ones((C, C), dtype=bool), -1)
    L = jnp.exp(jnp.where(incl, gc[..., :, None] - gc[..., None, :], -jnp.inf))
    kk = jnp.einsum('nbhik,nbhjk->nbhij', kc, kc)
    M = jnp.where(strict, bc[..., :, None] * kk * L, 0.0)
    A = M + jnp.eye(C, dtype=f32)
    rhs = jnp.concatenate([vc * bc[..., None], kc * (bc * jnp.exp(gc))[..., None]], axis=-1)
    sol = lax.linalg.triangular_solve(A, rhs, left_side=True, lower=True, unit_diagonal=True)
    u, w = sol[..., :GD_DV], sol[..., GD_DV:]
    qk = jnp.where(incl, jnp.einsum('nbhik,nbhjk->nbhij', qc, kc) * L, 0.0)
    qd = qc * jnp.exp(gc)[..., None]
    g_last = gc[..., -1]
    kd = kc * jnp.exp(g_last[..., None] - gc)[..., None]
    dl = jnp.exp(g_last)
    S0 = jnp.zeros((B, GD_HEADS, GD_DK, GD_DV), f32)
    _, o = lax.scan(_gdn_step, S0, (qd, qk, u, w, kd, dl))
    o = _rmsnorm(_unchunks(o), norm_w)
    o = o * jax.nn.silu(z.astype(f32)).reshape(B, T, GD_HEADS, GD_DV)
    return o.reshape(B, T, GD_HEADS * GD_DV).astype(q.dtype)


def _nsa(q, kc, vc, ks, vs, kw, vw, gate, pos_k, w1k, w2k, pos_v, w1v, w2v, cos, sin):
    B, T = q.shape[:2]
    dt = q.dtype
    f32 = jnp.float32
    G, hpg, dh = NSA_KV, NSA_HPG, HEAD_DIM
    scale = dh ** -0.5
    tpos = jnp.arange(T)
    q = _rope(q.reshape(B, T, NSA_HEADS, dh), cos, sin)
    q = q.reshape(B, T, G, hpg, dh).transpose(0, 2, 3, 1, 4)

    def heads(a, rot):
        a = a.reshape(B, T, G, dh)
        if rot:
            a = _rope(a, cos, sin)
        return a.transpose(0, 2, 1, 3)

    kc, vc = heads(kc, True), heads(vc, False)
    ks, vs = heads(ks, True), heads(vs, False)
    kw, vw = heads(kw, True), heads(vw, False)

    n_cmp = (T - CMP_LEN) // CMP_STRIDE + 1
    cstart = jnp.arange(n_cmp) * CMP_STRIDE
    bidx = cstart[:, None] + jnp.arange(CMP_LEN)[None, :]

    def compress(a, pos, w1, w2):
        blk = (a[:, :, bidx] + pos).reshape(B, G, n_cmp, CMP_LEN * dh)
        return jax.nn.gelu(blk @ w1) @ w2

    k_cmp = compress(kc, pos_k, w1k, w2k)
    v_cmp = compress(vc, pos_v, w1v, w2v)
    s = jnp.einsum('bghtd,bgnd->bghtn', q, k_cmp).astype(f32) * scale
    cmask = (cstart + CMP_LEN - 1)[None, :] <= tpos[:, None]
    p_cmp = jnp.where(cmask, jax.nn.softmax(jnp.where(cmask, s, NEG), axis=-1), 0.0)
    o_cmp = jnp.einsum('bghtn,bgnd->bghtd', p_cmp.astype(dt), v_cmp)

    n_slc = T // SLC_LEN
    sstart = jnp.arange(n_slc) * SLC_LEN
    overlap = jnp.clip(jnp.minimum(cstart[:, None] + CMP_LEN, sstart[None, :] + SLC_LEN)
                       - jnp.maximum(cstart[:, None], sstart[None, :]), 0).astype(f32) / CMP_LEN
    imp = jnp.einsum('bghtn,nj->bgtj', p_cmp, overlap)
    blk = jnp.arange(n_slc)[None, :]
    cur = (tpos // SLC_LEN)[:, None]
    forced = (blk == 0) | (blk == cur) | (blk == cur - 1)
    imp = jnp.where(forced, jnp.inf, imp)
    imp = jnp.where(sstart[None, :] <= tpos[:, None], imp, -jnp.inf)
    n_top = min(SLC_TOP, n_slc)
    _, sel = lax.top_k(imp, n_top)
    ks_b = ks.reshape(B, G, n_slc, SLC_LEN, dh)
    vs_b = vs.reshape(B, G, n_slc, SLC_LEN, dh)
    nqc = T // SLC_Q_CHUNK
    q_c = jnp.moveaxis(q.reshape(B, G, hpg, nqc, SLC_Q_CHUNK, dh), 3, 0)
    sel_c = jnp.moveaxis(sel.reshape(B, G, nqc, SLC_Q_CHUNK, n_top), 2, 0)
    t_c = tpos.reshape(nqc, SLC_Q_CHUNK)
    bi = jnp.arange(B)[:, None, None, None]
    gi = jnp.arange(G)[None, :, None, None]

    def slc_block(args):
        qb, sb, tb = args
        kg = ks_b[bi, gi, sb]
        vg = vs_b[bi, gi, sb]
        sc = jnp.einsum('bghqd,bgqkld->bghqkl', qb, kg).astype(f32) * scale
        kpos = sb[..., None] * SLC_LEN + jnp.arange(SLC_LEN)
        m = kpos <= tb[None, None, :, None, None]
        sc = jnp.where(m[:, :, None], sc, NEG)
        shp = sc.shape
        p = jax.nn.softmax(sc.reshape(shp[:4] + (-1,)), axis=-1).reshape(shp)
        return jnp.einsum('bghqkl,bgqkld->bghqd', p.astype(dt), vg)

    o_slc = lax.map(slc_block, (q_c, sel_c, t_c))
    o_slc = jnp.moveaxis(o_slc, 0, 3).reshape(B, G, hpg, T, dh)

    nwb = T // WIN_BLOCK
    slab = jnp.arange(nwb)[:, None] * WIN_BLOCK + jnp.arange(WINDOW + WIN_BLOCK)[None, :]
    kw_b = jnp.pad(kw, ((0, 0), (0, 0), (WINDOW, 0), (0, 0)))[:, :, slab]
    vw_b = jnp.pad(vw, ((0, 0), (0, 0), (WINDOW, 0), (0, 0)))[:, :, slab]
    qw = q.reshape(B, G, hpg, nwb, WIN_BLOCK, dh)
    sw = jnp.einsum('bghnqd,bgnsd->bghnqs', qw, kw_b).astype(f32) * scale
    qpos = (jnp.arange(nwb)[:, None] * WIN_BLOCK + jnp.arange(WIN_BLOCK)[None, :])[:, :, None]
    kpos = (slab - WINDOW)[:, None, :]
    wmask = (kpos <= qpos) & (kpos > qpos - WINDOW) & (kpos >= 0)
    pw = jax.nn.softmax(jnp.where(wmask, sw, NEG), axis=-1)
    o_win = jnp.einsum('bghnqs,bgnsd->bghnqd', pw.astype(dt), vw_b).reshape(B, G, hpg, T, dh)

    gts = jax.nn.sigmoid(gate.astype(f32)).reshape(B, T, G, hpg, 3).transpose(0, 2, 3, 1, 4)
    gts = gts.astype(dt)
    o = gts[..., 0:1] * o_cmp + gts[..., 1:2] * o_slc + gts[..., 2:3] * o_win
    return o.transpose(0, 3, 1, 2, 4).reshape(B, T, NSA_W)


def setup_inputs(seed: int = 0) -> dict:
    key = jax.random.key(seed)
    ks = jax.random.split(key, 24)
    f32 = jnp.float32

    def nrm(k, shape, scale):
        return jax.random.normal(k, shape, f32) * scale

    dt = jnp.exp(jax.random.uniform(ks[14], (DEPTH, GD_HEADS), f32, math.log(1e-3), math.log(1e-1)))
    return {
        "x": nrm(ks[0], (BATCH, SEQ, D_MODEL), 1.0),
        "attn_norm": 1.0 + nrm(ks[1], (DEPTH, D_MODEL), 0.02),
        "w_in": nrm(ks[2], (DEPTH, D_MODEL, N_IN), D_MODEL ** -0.5),
        "w_out": nrm(ks[3], (DEPTH, MIX_W, D_MODEL), MIX_W ** -0.5),
        "ffn_norm": 1.0 + nrm(ks[4], (DEPTH, D_MODEL), 0.02),
        "w_gate": nrm(ks[5], (DEPTH, D_MODEL, FFN_HIDDEN), D_MODEL ** -0.5),
        "w_up": nrm(ks[6], (DEPTH, D_MODEL, FFN_HIDDEN), D_MODEL ** -0.5),
        "w_down": nrm(ks[7], (DEPTH, FFN_HIDDEN, D_MODEL), FFN_HIDDEN ** -0.5),
        "final_norm": 1.0 + nrm(ks[8], (D_MODEL,), 0.02),
        "hgrn_lb_logits": nrm(ks[9], (DEPTH, HG_W), 1.0),
        "hgrn_out_norm": 1.0 + nrm(ks[10], (DEPTH, HG_DV), 0.02),
        "gdn_conv": nrm(ks[11], (DEPTH, CONV_W, GD_CONV_C), CONV_W ** -0.5),
        "gdn_A_log": jnp.log(jax.random.uniform(ks[12], (DEPTH, GD_HEADS), f32, 1.0, 16.0)),
        "gdn_dt_bias": dt + jnp.log(-jnp.expm1(-dt)),
        "gdn_out_norm": 1.0 + nrm(ks[13], (DEPTH, GD_DV), 0.02),
        "cmp_pos_k": nrm(ks[15], (DEPTH, CMP_LEN, HEAD_DIM), 0.1),
        "cmp_w1_k": nrm(ks[16], (DEPTH, CMP_LEN * HEAD_DIM, CMP_HIDDEN), (CMP_LEN * HEAD_DIM) ** -0.5),
        "cmp_w2_k": nrm(ks[17], (DEPTH, CMP_HIDDEN, HEAD_DIM), CMP_HIDDEN ** -0.5),
        "cmp_pos_v": nrm(ks[18], (DEPTH, CMP_LEN, HEAD_DIM), 0.1),
        "cmp_w1_v": nrm(ks[19], (DEPTH, CMP_LEN * HEAD_DIM, CMP_HIDDEN), (CMP_LEN * HEAD_DIM) ** -0.5),
        "cmp_w2_v": nrm(ks[20], (DEPTH, CMP_HIDDEN, HEAD_DIM), CMP_HIDDEN ** -0.5),
    }


def reference(x, attn_norm, w_in, w_out, ffn_norm, w_gate, w_up, w_down, final_norm,
              hgrn_lb_logits, hgrn_out_norm, gdn_conv, gdn_A_log, gdn_dt_bias, gdn_out_norm,
              cmp_pos_k, cmp_w1_k, cmp_w2_k, cmp_pos_v, cmp_w1_v, cmp_w2_v):
    T = x.shape[1]
    cos, sin = _rope_tables(T)
    lb_p = jax.nn.softmax(hgrn_lb_logits.astype(jnp.float32), axis=0)
    lb_all = jnp.concatenate([jnp.zeros_like(lb_p[:1]), jnp.cumsum(lb_p, axis=0)[:-1]], axis=0)
    split_at = [int(v) for v in np.cumsum(IN_SIZES)[:-1]]
    for l in range(DEPTH):
        h = _rmsnorm(x, attn_norm[l])
        parts = jnp.split(h @ w_in[l], split_at, axis=-1)
        (hq, hf, hi, hg, gq, gk, gv, gz, ga, gb,
         nq, nkc, nvc, nks, nvs, nkw, nvw, ngate) = parts
        o_a = _hgrn2(hq, hf, hi, hg, lb_all[l], hgrn_out_norm[l])
        o_b = _gdn(gq, gk, gv, gz, ga, gb, gdn_conv[l], gdn_A_log[l], gdn_dt_bias[l], gdn_out_norm[l])
        o_c = _nsa(nq, nkc, nvc, nks, nvs, nkw, nvw, ngate,
                   cmp_pos_k[l], cmp_w1_k[l], cmp_w2_k[l], cmp_pos_v[l], cmp_w1_v[l], cmp_w2_v[l],
                   cos, sin)
        x = x + jnp.concatenate([o_a, o_b, o_c], axis=-1) @ w_out[l]
        h = _rmsnorm(x, ffn_norm[l])
        x = x + (jax.nn.silu(h @ w_gate[l]) * (h @ w_up[l])) @ w_down[l]
    return _rmsnorm(x, final_norm)
```

```cpp
#include <hip/hip_runtime.h>
#include <cstdio>
#include <cstdint>
namespace pg8 {
#define PG8_LAS __attribute__((address_space(3)))
typedef unsigned short bf16_t;
typedef short bf16x8 __attribute__((ext_vector_type(8)));
typedef float f32x4 __attribute__((ext_vector_type(4)));
typedef unsigned u32x4 __attribute__((ext_vector_type(4)));
constexpr int BM = 256, BK = 64, HALF = 128, HTB = HALF * BK * 2  , STAGE_BYTES = 8 * HTB, NXCD = 8, WGM = 4;

__host__ __device__ __forceinline__ int lds_byte(int r, int c) { const int st = (r >> 4) * 2 + (c >> 5), rr = r & 15, cc = c & 31, ob = rr * 64 + cc * 2; return st * 1024 + (ob ^ (((ob >> 9) & 1) << 5)); }
__host__ __device__ __forceinline__ void stage_rc(int b, int& R, int& C) { const int st = b / 1024, sb = b % 1024, swz = sb ^ (((sb >> 9) & 1) << 5); R = (st >> 1) * 16 + swz / 64; C = (st & 1) * 32 + (swz % 64) / 2; }
__host__ __device__ __forceinline__ int perm32(int rho) { const int n = rho >> 4, i = rho & 15; return 8 * (i >> 2) + 4 * n + (i & 3); }

struct Unit { int pm, pn, ko = 0; };
struct Gemm { const bf16_t* A; const bf16_t* Bt; int M, N, K; int lda = 0, ldb = 0; };

struct StaticOrder {
    int nM, nN, nwg, G, c;
    __host__ __device__ void init(int M, int N, int G_, int c_) { nM = M / BM; nN = N / BM; nwg = nM * nN; G = G_; c = c_; }
    __host__ __device__ bool next(int i, Unit& u) const {
        const long L = (long)i * G + c; if (L >= nwg) return false;
        int wgid = (int)L; { const int q = nwg / NXCD, r = nwg % NXCD, xcd = wgid % NXCD, off = wgid / NXCD; wgid = (xcd < r ? xcd * (q + 1) : r * (q + 1) + (xcd - r) * q) + off; }
        const int nig = WGM * nN, gid = wgid / nig, fm = gid * WGM, gsz = (nM - fm) < WGM ? (nM - fm) : WGM;
        u.pm = fm + ((wgid % nig) % gsz); u.pn = (wgid % nig) / gsz; return true;
    }
    __device__ __forceinline__ void a_ready(const Unit&) const {}
    __device__ __forceinline__ void done(const Unit&) const {}
};
typedef float f32x2 __attribute__((ext_vector_type(2)));
typedef unsigned u32x2 __attribute__((ext_vector_type(2)));
typedef __bf16 bf16x2_t __attribute__((ext_vector_type(2)));
__device__ __forceinline__ unsigned cvt_pk_bf16(float lo, float hi) { f32x2 v = {lo, hi}; bf16x2_t r = __builtin_convertvector(v, bf16x2_t); return __builtin_bit_cast(unsigned, r); }

struct EpiIn {
    static constexpr bool PERM = true, AFTER_DRAIN = false;
    bf16_t* Ybf; float* Yf; int ldy, ldf, nbf; const unsigned long long* rs; float inv_k, eps;
    __device__ __forceinline__ void operator()(const f32x4 (&acc)[2][2][4][2], const Unit& u, int wr, int wc, int fr, int fq) const {
        const int row0 = u.pm * BM + wr * 64 + fr;
        float rr[2][4];
#pragma unroll
        for (int ai = 0; ai < 2; ++ai)
#pragma unroll
            for (int m = 0; m < 4; ++m) rr[ai][m] = 1.0f / sqrtf((float)rs[row0 + ai * HALF + m * 16] * (inv_k * (1.0f / 1048576.0f)) + eps);
        if (u.pn < nbf) {
            const int col0 = u.pn * BM + wc * 32 + 8 * fq;
#pragma unroll
            for (int ai = 0; ai < 2; ++ai)
#pragma unroll
                for (int m = 0; m < 4; ++m) { bf16_t* rowp = Ybf + (size_t)(row0 + ai * HALF + m * 16) * ldy + col0;
#pragma unroll
                    for (int bj = 0; bj < 2; ++bj) { const f32x4 v0 = acc[ai][bj][m][0] * rr[ai][m], v1 = acc[ai][bj][m][1] * rr[ai][m];
                        u32x4 w; w.x = cvt_pk_bf16(v0[0], v0[1]); w.y = cvt_pk_bf16(v0[2], v0[3]); w.z = cvt_pk_bf16(v1[0], v1[1]); w.w = cvt_pk_bf16(v1[2], v1[3]);
                        *(u32x4*)(rowp + bj * HALF) = w; } }
        } else {
            const int col0 = (u.pn - nbf) * BM + wc * 32 + 8 * fq;
#pragma unroll
            for (int ai = 0; ai < 2; ++ai)
#pragma unroll
                for (int m = 0; m < 4; ++m) { float* rowp = Yf + (size_t)(row0 + ai * HALF + m * 16) * ldf + col0;
#pragma unroll
                    for (int bj = 0; bj < 2; ++bj) { *(f32x4*)(rowp + bj * HALF) = acc[ai][bj][m][0] * rr[ai][m]; *(f32x4*)(rowp + bj * HALF + 4) = acc[ai][bj][m][1] * rr[ai][m]; } }
        }
    }
};
struct EpiRes {
    static constexpr bool PERM = false, AFTER_DRAIN = false;
    bf16_t* C0; int ldc; size_t split_stride;
    __device__ __forceinline__ void operator()(const f32x4 (&acc)[2][2][4][2], const Unit& u, int wr, int wc, int fr, int fq) const {
        bf16_t* C = C0 + (size_t)(u.ko >> 9) * split_stride;
        const int row0 = u.pm * BM + wr * 64 + fr, col0 = u.pn * BM + wc * 32 + 4 * fq;
#pragma unroll
        for (int ai = 0; ai < 2; ++ai)
#pragma unroll
            for (int m = 0; m < 4; ++m) { const size_t off = (size_t)(row0 + ai * HALF + m * 16) * ldc + col0;
#pragma unroll
                for (int bj = 0; bj < 2; ++bj)
#pragma unroll
                    for (int n = 0; n < 2; ++n) { const f32x4 v = acc[ai][bj][m][n]; u32x2 w; w.x = cvt_pk_bf16(v[0], v[1]); w.y = cvt_pk_bf16(v[2], v[3]); *(u32x2*)(C + off + bj * HALF + n * 16) = w; } }
    }
};
struct EpiResNorm {
    static constexpr bool PERM = true, AFTER_DRAIN = false;
    const float* basef; const bf16_t* Hin; bf16_t* Hb; unsigned long long* rs; int ldc;
    __device__ __forceinline__ void operator()(const f32x4 (&acc)[2][2][4][2], const Unit& u, int wr, int wc, int fr, int fq) const {
        const int row0 = u.pm * BM + wr * 64 + fr, col0 = u.pn * BM + wc * 32 + 8 * fq;
#pragma unroll
        for (int ai = 0; ai < 2; ++ai)
#pragma unroll
            for (int m = 0; m < 4; ++m) { const int row = row0 + ai * HALF + m * 16; const size_t off = (size_t)row * ldc + col0; float ss = 0.f;
#pragma unroll
                for (int bj = 0; bj < 2; ++bj) { f32x4 b0, b1;
                    if (basef) { b0 = *(const f32x4*)(basef + off + bj * HALF); b1 = *(const f32x4*)(basef + off + bj * HALF + 4); }
                    else { const u32x4 bw = *(const u32x4*)(Hin + off + bj * HALF);
                        b0 = (f32x4){__builtin_bit_cast(float, bw.x << 16), __builtin_bit_cast(float, bw.x & 0xffff0000u), __builtin_bit_cast(float, bw.y << 16), __builtin_bit_cast(float, bw.y & 0xffff0000u)};
                        b1 = (f32x4){__builtin_bit_cast(float, bw.z << 16), __builtin_bit_cast(float, bw.z & 0xffff0000u), __builtin_bit_cast(float, bw.w << 16), __builtin_bit_cast(float, bw.w & 0xffff0000u)}; }
                    const f32x4 v0 = acc[ai][bj][m][0] + b0, v1 = acc[ai][bj][m][1] + b1;
                    u32x4 w; w.x = cvt_pk_bf16(v0[0], v0[1]); w.y = cvt_pk_bf16(v0[2], v0[3]); w.z = cvt_pk_bf16(v1[0], v1[1]); w.w = cvt_pk_bf16(v1[2], v1[3]);
                    *(u32x4*)(Hb + off + bj * HALF) = w;
                    ss += ((v0[0] * v0[0] + v0[1] * v0[1]) + (v0[2] * v0[2] + v0[3] * v0[3])) + ((v1[0] * v1[0] + v1[1] * v1[1]) + (v1[2] * v1[2] + v1[3] * v1[3])); }
                { const auto r16_ = __builtin_amdgcn_permlane16_swap(__float_as_uint(ss), __float_as_uint(ss), false, false); ss = __uint_as_float(r16_[0]) + __uint_as_float(r16_[1]);
                  const auto r32_ = __builtin_amdgcn_permlane32_swap(__float_as_uint(ss), __float_as_uint(ss), false, false); ss = __uint_as_float(r32_[0]) + __uint_as_float(r32_[1]); }
                if (fq == 0) atomicAdd(rs + row, (unsigned long long)(ss * 1048576.0f + 0.5f)); }
    }
};
struct EpiSwiGLU {
    static constexpr bool PERM = true, AFTER_DRAIN = false;
    bf16_t* O; int ldc; const unsigned long long* rs; float inv_k, eps;
    __device__ __forceinline__ void operator()(const f32x4 (&acc)[2][2][4][2], const Unit& u, int wr, int wc, int fr, int fq) const {
        const int row0 = u.pm * BM + wr * 64 + fr, col0 = u.pn * HALF + wc * 32 + 8 * fq;
#pragma unroll
        for (int ai = 0; ai < 2; ++ai)
#pragma unroll
            for (int m = 0; m < 4; ++m) { bf16_t* rowp = O + (size_t)(row0 + ai * HALF + m * 16) * ldc + col0;
                float r[8]; const float rr = 1.0f / sqrtf((float)rs[row0 + ai * HALF + m * 16] * (inv_k * (1.0f / 1048576.0f)) + eps);
#pragma unroll
                for (int n = 0; n < 2; ++n)
#pragma unroll
                    for (int j = 0; j < 4; ++j) { const float g = acc[ai][0][m][n][j] * rr, up = acc[ai][1][m][n][j] * rr; r[4 * n + j] = g * up * __builtin_amdgcn_rcpf(1.0f + __expf(-g)); }
                u32x4 w; w.x = cvt_pk_bf16(r[0], r[1]); w.y = cvt_pk_bf16(r[2], r[3]); w.z = cvt_pk_bf16(r[4], r[5]); w.w = cvt_pk_bf16(r[6], r[7]);
                *(u32x4*)rowp = w; }
    }
};
struct CmpOrder {
    int G, c;
    __device__ __forceinline__ bool next(int i, Unit& u) const { const int L = i * G + c; if (L >= 128) return false; const int b = L >> 2, kv = b >> 4; u.pm = 8 * kv + (b & 7); u.pn = 2 * kv + ((b >> 3) & 1); u.ko = (L & 3) * 512; return true; }
    __device__ __forceinline__ void a_ready(const Unit&) const {}
    __device__ __forceinline__ void done(const Unit&) const {}
};
template <class Epi, class Sched, bool ALIGN_EPI = false, bool SP2 = false>
__device__ __forceinline__ void gemm_phase(PG8_LAS unsigned char* lds, const Gemm g, const Sched& S, const Epi& E, const int wv  ) {
    unsigned zl_ = 0u; asm volatile("" : "+s"(zl_)); int tid_ = wv * 64 + (int)__builtin_amdgcn_mbcnt_hi(~0u, __builtin_amdgcn_mbcnt_lo(~0u, zl_)); asm volatile("" : "+v"(tid_));
    const int tid = tid_, wid = __builtin_amdgcn_readfirstlane(tid >> 6), lane = tid & 63, wr = wid >> 2, wc = wid & 3, fr = lane & 15, fq = lane >> 4;
    const int K = g.K, nt = K / BK, lda = g.lda ? g.lda : K, ldb = g.ldb ? g.ldb : K;
    unsigned voffA[2], voffB[2];
#pragma unroll
    for (int i = 0; i < 2; ++i) { int R, C; stage_rc(tid * 16 + i * 8192, R, C); const int Rb = Epi::PERM ? ((R & ~31) + perm32(R & 31)) : R;
        voffA[i] = (unsigned)(R * lda + C) * 2u; voffB[i] = (unsigned)(Rb * ldb + C) * 2u; }
    const size_t kstep = (size_t)(BK * 2);
    const size_t hstepA = (size_t)HALF * lda * 2, hstepB = (size_t)HALF * ldb * 2;
    const size_t tstepA = 2 * hstepA, tstepB = 2 * hstepB;
    const unsigned ldsw = (unsigned)wid * 1024u;
    const int aoff = lds_byte(wr * 64 + fr, fq * 8), boff = lds_byte(wc * 32 + fr, fq * 8);
#define PG8_SA(b, h) (((b) * 2 + (h)) * HTB)
#define PG8_SB(b, h) ((4 + (b) * 2 + (h)) * HTB)
#define PG8_STAGE(bufoff, gbase, voff) do { _Pragma("unroll") for (int _i = 0; _i < 2; ++_i) \
        __builtin_amdgcn_global_load_lds((const unsigned*)((const char*)(gbase) + (voff)[_i]), (PG8_LAS unsigned*)(lds + (bufoff) + ldsw + _i * 8192), 16, 0, 0); } while (0)
#define PG8_LDA(dst, b, h) do { _Pragma("unroll") for (int m = 0; m < 4; ++m) _Pragma("unroll") for (int k = 0; k < 2; ++k) dst[m][k] = *(const PG8_LAS bf16x8*)(lds + PG8_SA(b, h) + aoff + m * 2048 + k * 1024); } while (0)
#define PG8_LDB(dst, b, h) do { _Pragma("unroll") for (int n = 0; n < 2; ++n) _Pragma("unroll") for (int k = 0; k < 2; ++k) dst[n][k] = *(const PG8_LAS bf16x8*)(lds + PG8_SB(b, h) + boff + n * 2048 + k * 1024); } while (0)
#define PG8_MMA(ai, bj, At, Bt) do { __builtin_amdgcn_s_setprio(1); _Pragma("unroll") for (int m = 0; m < 4; ++m) _Pragma("unroll") for (int n = 0; n < 2; ++n) _Pragma("unroll") for (int k = 0; k < 2; ++k) \
        acc[ai][bj][m][n] = __builtin_amdgcn_mfma_f32_16x16x32_bf16(Bt[n][k], At[m][k], acc[ai][bj][m][n], 0, 0, 0); __builtin_amdgcn_s_setprio(0); } while (0)
#define PG8_WAIT_V(n) asm volatile("s_waitcnt vmcnt(" #n ")" ::: "memory")
#define PG8_WAIT_L(n) asm volatile("s_waitcnt lgkmcnt(" #n ")" ::: "memory")
#define PG8_BAR __builtin_amdgcn_s_barrier()
#define PG8_SCHED __builtin_amdgcn_sched_barrier(0)
    Unit cur, nxt; int ui = 0;
    if (!S.next(0, cur)) return;
    f32x4 acc[2][2][4][2];
#pragma unroll
    for (int a = 0; a < 2; ++a)
#pragma unroll
        for (int b = 0; b < 2; ++b)
#pragma unroll
            for (int m = 0; m < 4; ++m)
#pragma unroll
                for (int n = 0; n < 2; ++n) acc[a][b][m][n] = (f32x4){0.f, 0.f, 0.f, 0.f};
    bf16x8 At[4][2], B0[2][2], B1[2][2];
    const char* cA = (const char*)g.A + (size_t)cur.pm * tstepA + (size_t)cur.ko * 2; const char* cB = (const char*)g.Bt + (size_t)cur.pn * tstepB + (size_t)cur.ko * 2;
    S.a_ready(cur);
    if constexpr (SP2) {
        PG8_STAGE(PG8_SB(0, 0), cB, voffB); PG8_STAGE(PG8_SB(0, 1), cB + hstepB, voffB); PG8_STAGE(PG8_SA(0, 0), cA, voffA); PG8_STAGE(PG8_SA(0, 1), cA + hstepA, voffA);
        if (wr == 1) PG8_BAR;
        PG8_WAIT_V(2); PG8_BAR;
        PG8_STAGE(PG8_SB(1, 0), cB + kstep, voffB); PG8_STAGE(PG8_SA(1, 0), cA + kstep, voffA); PG8_STAGE(PG8_SB(1, 1), cB + hstepB + kstep, voffB);
        PG8_WAIT_V(6); PG8_BAR;
    } else {
        PG8_STAGE(PG8_SB(0, 0), cB, voffB); PG8_STAGE(PG8_SA(0, 0), cA, voffA); PG8_STAGE(PG8_SB(0, 1), cB + hstepB, voffB); PG8_STAGE(PG8_SA(0, 1), cA + hstepA, voffA);
        if (wr == 1) PG8_BAR;
        PG8_WAIT_V(4); PG8_BAR;
        PG8_STAGE(PG8_SB(1, 0), cB + kstep, voffB); PG8_STAGE(PG8_SA(1, 0), cA + kstep, voffA); PG8_STAGE(PG8_SB(1, 1), cB + hstepB + kstep, voffB);
        PG8_WAIT_V(6); PG8_BAR;
    }
    for (;;) {
        const bool has_next = S.next(ui + 1, nxt);
        const char* nA = has_next ? (const char*)g.A + (size_t)nxt.pm * tstepA + (size_t)nxt.ko * 2 : cA; const char* nB = has_next ? (const char*)g.Bt + (size_t)nxt.pn * tstepB + (size_t)nxt.ko * 2 : cB;
        for (int t = 0; t < nt; t += 2) {
            const bool last = (t == nt - 2);
            const char* a1 = cA + (size_t)(t + 1) * kstep;
            const char* a2 = last ? nA : cA + (size_t)(t + 2) * kstep; const char* b2 = last ? nB : cB + (size_t)(t + 2) * kstep;
            const char* a3 = a2 + kstep; const char* b3 = b2 + kstep;
            if (last && has_next) S.a_ready(nxt);
            if constexpr (SP2) {
            PG8_LDB(B0, 0, 0); PG8_LDB(B1, 0, 1); PG8_SCHED; PG8_LDA(At, 0, 0); PG8_STAGE(PG8_SA(1, 1), a1 + hstepA, voffA);
            PG8_WAIT_V(8); PG8_WAIT_L(0); PG8_BAR; PG8_MMA(0, 0, At, B0); PG8_MMA(0, 1, At, B1); PG8_BAR; PG8_SCHED;
            PG8_LDA(At, 0, 1); PG8_STAGE(PG8_SB(0, 0), b2, voffB); PG8_STAGE(PG8_SB(0, 1), b2 + hstepB, voffB); PG8_STAGE(PG8_SA(0, 0), a2, voffA);
            PG8_WAIT_V(8); PG8_WAIT_L(0); PG8_BAR; PG8_MMA(1, 0, At, B0); PG8_MMA(1, 1, At, B1); PG8_BAR; PG8_SCHED;
            PG8_LDB(B0, 1, 0); PG8_LDB(B1, 1, 1); PG8_SCHED; PG8_LDA(At, 1, 0); PG8_STAGE(PG8_SA(0, 1), a2 + hstepA, voffA);
            PG8_WAIT_V(8); PG8_WAIT_L(0); PG8_BAR; PG8_MMA(0, 0, At, B0); PG8_MMA(0, 1, At, B1); PG8_BAR; PG8_SCHED;
            PG8_LDA(At, 1, 1); PG8_STAGE(PG8_SB(1, 0), b3, voffB); PG8_STAGE(PG8_SB(1, 1), b3 + hstepB, voffB); PG8_STAGE(PG8_SA(1, 0), a3, voffA);
            PG8_WAIT_V(8); PG8_WAIT_L(0); PG8_BAR; PG8_MMA(1, 0, At, B0); PG8_MMA(1, 1, At, B1); PG8_BAR; PG8_SCHED;
            } else {
            PG8_LDB(B0, 0, 0); PG8_SCHED; PG8_LDA(At, 0, 0); PG8_STAGE(PG8_SA(1, 1), a1 + hstepA, voffA);
            PG8_WAIT_L(8); PG8_BAR; PG8_WAIT_L(0); PG8_MMA(0, 0, At, B0); PG8_BAR; PG8_SCHED;
            PG8_LDB(B1, 0, 1); PG8_STAGE(PG8_SB(0, 0), b2, voffB);
            PG8_BAR; PG8_WAIT_L(0); PG8_MMA(0, 1, At, B1); PG8_BAR;
            PG8_LDA(At, 0, 1); PG8_STAGE(PG8_SA(0, 0), a2, voffA);
            PG8_BAR; PG8_WAIT_L(0); PG8_MMA(1, 0, At, B0); PG8_BAR; PG8_SCHED;
            PG8_STAGE(PG8_SB(0, 1), b2 + hstepB, voffB);
            PG8_WAIT_V(6); PG8_BAR; PG8_MMA(1, 1, At, B1); PG8_BAR;
            PG8_LDB(B0, 1, 0); PG8_SCHED; PG8_LDA(At, 1, 0); PG8_STAGE(PG8_SA(0, 1), a2 + hstepA, voffA);
            PG8_WAIT_L(8); PG8_BAR; PG8_WAIT_L(0); PG8_MMA(0, 0, At, B0); PG8_BAR; PG8_SCHED;
            PG8_LDB(B1, 1, 1); PG8_STAGE(PG8_SB(1, 0), b3, voffB);
            PG8_BAR; PG8_WAIT_L(0); PG8_MMA(0, 1, At, B1); PG8_BAR;
            PG8_LDA(At, 1, 1); PG8_STAGE(PG8_SA(1, 0), a3, voffA);
            PG8_BAR; PG8_WAIT_L(0); PG8_MMA(1, 0, At, B0); PG8_BAR; PG8_SCHED;
            PG8_STAGE(PG8_SB(1, 1), b3 + hstepB, voffB);
            PG8_WAIT_V(6); PG8_BAR; PG8_MMA(1, 1, At, B1); PG8_BAR;
            }
        }
        if constexpr (ALIGN_EPI) { if (wr == 0) PG8_BAR; }
        if constexpr (!Epi::AFTER_DRAIN) { E(acc, cur, wr, wc, fr, fq); S.done(cur); }
        if (!has_next) break;
#pragma unroll
        for (int a = 0; a < 2; ++a)
#pragma unroll
            for (int b = 0; b < 2; ++b)
#pragma unroll
                for (int m = 0; m < 4; ++m)
#pragma unroll
                    for (int n = 0; n < 2; ++n) acc[a][b][m][n] = (f32x4){0.f, 0.f, 0.f, 0.f};
        cur = nxt; cA = nA; cB = nB; ++ui;
        if constexpr (ALIGN_EPI) { if (wr == 1) PG8_BAR; }
    }
    PG8_WAIT_V(0);
    if constexpr (!ALIGN_EPI) { if (wr == 0) PG8_BAR; }
    PG8_BAR;
    if constexpr (Epi::AFTER_DRAIN) { E.fused(acc, cur, wr, wc, fr, fq, lds, wid, lane); S.done(cur); }
#undef PG8_SA
#undef PG8_SB
#undef PG8_STAGE
#undef PG8_LDA
#undef PG8_LDB
#undef PG8_MMA
#undef PG8_WAIT_V
#undef PG8_WAIT_L
#undef PG8_BAR
#undef PG8_SCHED
}
}
#define GAS __attribute__((address_space(1)))
#define LAS __attribute__((address_space(3)))
#define XB_TMO      128
#define XB_XCNT(j)  (256  + 64 * (j))
#define XB_XSUB(j)  (1280 + 64 * (j))
#define XB_XGEN(j)  (2304 + 64 * (j))
#define XB_TOP      3328
#define XB_TOPGEN   3392
#define XCD_BAR_WORDS 3456
#define XB_SPIN_CAP (1u << 18)

__device__ __forceinline__ unsigned xb_ld(unsigned* p)              { return __hip_atomic_load(p, __ATOMIC_RELAXED, __HIP_MEMORY_SCOPE_AGENT); }
__device__ __forceinline__ unsigned xb_add(unsigned* p, unsigned v) { return __hip_atomic_fetch_add(p, v, __ATOMIC_RELAXED, __HIP_MEMORY_SCOPE_AGENT); }
__device__ __forceinline__ unsigned xb_xcc_id() { return (unsigned)__builtin_amdgcn_s_getreg((3 << 11) | 20) & 0xFu; }
#define XB_SPIN(cond, bar) do { unsigned _sp = 0; while (cond) { __builtin_amdgcn_s_sleep(1); \
    if ((++_sp & 255u) == 0u) { if (xb_ld(&(bar)[XB_TMO])) break; if (_sp > XB_SPIN_CAP) { atomicAdd(&(bar)[XB_TMO], 1u); break; } } } } while (0)

struct XcdBarrier {
    int wv;
    unsigned* bar; unsigned x;
    volatile LAS unsigned* st;
};

__device__ __forceinline__ XcdBarrier xcd_barrier_post(unsigned* bar, volatile LAS unsigned* st) {
    XcdBarrier b; b.bar = bar; b.x = xb_xcc_id(); b.st = st;
    if (threadIdx.x == 0) (void)xb_add(&bar[XB_XCNT(b.x)], 1u);
    return b;
}
__device__ __forceinline__ void xcd_barrier_complete(unsigned* bar, unsigned x, unsigned& nloc, unsigned& nx) {
    const unsigned G = gridDim.x * gridDim.y * gridDim.z;
    unsigned sum, cnt, mine, sp = 0u;
    for (;;) {
        sum = 0u; cnt = 0u; mine = 0u;
#pragma unroll
        for (unsigned j = 0; j < 16; ++j) { const unsigned c = xb_ld(&bar[XB_XCNT(j)]); sum += c; cnt += (c > 0u) ? 1u : 0u; mine = (j == x) ? c : mine; }
        if (sum == G) break;
        __builtin_amdgcn_s_sleep(1);
        if ((++sp & 255u) == 0u) { if (xb_ld(&bar[XB_TMO])) break; if (sp > XB_SPIN_CAP) { atomicAdd(&bar[XB_TMO], 1u); break; } }
    }
    nloc = mine > 0u ? mine : 1u; nx = cnt > 0u ? cnt : 1u;
}

__device__ __forceinline__ void xcd_barrier(const XcdBarrier& b) {
    asm volatile("s_waitcnt vmcnt(0)" ::: "memory");
    __syncthreads();
    unsigned zl_ = 0u; asm volatile("" : "+s"(zl_));
    if (b.wv == 0 && __builtin_amdgcn_mbcnt_hi(~0u, __builtin_amdgcn_mbcnt_lo(~0u, zl_)) == 0u) {
        unsigned* bar = b.bar;
        __builtin_amdgcn_s_waitcnt(0);
        unsigned nloc = b.st[0], nx = b.st[1];
        if (nloc == 0u) { xcd_barrier_complete(bar, b.x, nloc, nx); b.st[0] = nloc; b.st[1] = nx; }
        const unsigned old = xb_add(&bar[XB_XSUB(b.x)], 1u);
        const unsigned gen = old / nloc;
        if (old + 1u == (gen + 1u) * nloc) {
            __builtin_amdgcn_fence(__ATOMIC_RELEASE, "agent");
            asm volatile("s_waitcnt vmcnt(0)" ::: "memory");
            const unsigned og = xb_add(&bar[XB_TOP], 1u);
            const unsigned tg = og / nx;
            if (og + 1u == (tg + 1u) * nx) xb_add(&bar[XB_TOPGEN], 1u);
            else XB_SPIN(xb_ld(&bar[XB_TOPGEN]) == tg, bar);
            __builtin_amdgcn_fence(__ATOMIC_ACQUIRE, "agent");
            xb_add(&bar[XB_XGEN(b.x)], 1u);
            asm volatile("s_waitcnt vmcnt(0)" ::: "memory");
        } else {
            XB_SPIN(xb_ld(&bar[XB_XGEN(b.x)]) == gen, bar);
            __builtin_amdgcn_fence(__ATOMIC_ACQUIRE, "agent");
            asm volatile("s_waitcnt vmcnt(0)" ::: "memory");
        }
    }
    __syncthreads();
}
namespace hy {
#define DI __device__ __forceinline__
typedef unsigned short bf16_t;
typedef short bf16x8 __attribute__((ext_vector_type(8)));
typedef short s16x4 __attribute__((ext_vector_type(4)));
typedef short v4i16_t __attribute__((ext_vector_type(4)));
typedef float f32x2 __attribute__((ext_vector_type(2)));
typedef float f32x4 __attribute__((ext_vector_type(4)));
typedef float f32x16 __attribute__((ext_vector_type(16)));
typedef unsigned u32x2 __attribute__((ext_vector_type(2)));
typedef unsigned u32x4 __attribute__((ext_vector_type(4)));
typedef __bf16 bf16x2_t __attribute__((ext_vector_type(2)));

constexpr int DM = 4096, NB = 4, T = 2048, M = NB * T, DEPTH = 2;
constexpr int NIN = 13376, NINP = 13568, LDY = 12288, LDF = 1280, NBF_TILES = 48;
constexpr int FF = 11008;
constexpr int NCHUNK = T / 64;
constexpr float NORM_EPS = 1e-6f;
constexpr int Y_HQ = 0, Y_HI = 1024, Y_HG = 2048, Y_GQ = 3072, Y_GK = 4096, Y_GV = 5120, Y_GZ = 6144, Y_NQ = 7168, Y_KC = 9216, Y_VC = 9728, Y_KS = 10240, Y_VS = 10752, Y_KW = 11264, Y_VW = 11776;
constexpr int F_HF = 0, F_GA = 1024, F_GB = 1032, F_GATE = 1040;
enum { IN_X = 0, IN_ATTN_NORM, IN_W_IN, IN_W_OUT, IN_FFN_NORM, IN_W_GATE, IN_W_UP, IN_W_DOWN, IN_FINAL_NORM, IN_LB, IN_HG_NORM, IN_CONV, IN_ALOG, IN_DTB, IN_GD_NORM,
       IN_POS_K, IN_W1_K, IN_W2_K, IN_POS_V, IN_W1_V, IN_W2_V, N_INPUTS };

constexpr size_t al256(size_t x) { return (x + 255) & ~(size_t)255; }
constexpr size_t WS_CTL = 0, CTL_BYTES = 1u << 20;
constexpr size_t WS_ROPE_C = WS_CTL + CTL_BYTES;
constexpr size_t WS_ROPE_S = WS_ROPE_C + (size_t)T * 64 * 4;
constexpr size_t WS_C1 = WS_ROPE_S + (size_t)T * 64 * 4;
constexpr size_t WS_RSA = WS_C1 + 2 * 8 * 256 * 4;
constexpr size_t WS_RSB = WS_RSA + (size_t)M * 8;
constexpr size_t WS_W2T = al256(WS_RSB + (size_t)M * 8);
constexpr size_t WS_W1CAT = WS_W2T + (size_t)2 * 128 * 256 * 2;
constexpr size_t WS_WIN = WS_W1CAT + (size_t)2 * 512 * 2048 * 2;
constexpr size_t WS_WOUT = WS_WIN + (size_t)NINP * DM * 2;
constexpr size_t WS_WGU = WS_WOUT + (size_t)DM * DM * 2;
constexpr size_t WS_WD = WS_WGU + (size_t)2 * FF * DM * 2;
constexpr size_t WS_H = WS_WD + (size_t)DM * FF * 2;
constexpr size_t WS_YBF = WS_H + (size_t)M * DM * 2;
constexpr size_t WS_YF = WS_YBF + (size_t)M * LDY * 2;
constexpr size_t WS_XA = WS_YF + (size_t)M * LDF * 4;
constexpr size_t WS_XB = WS_XA + (size_t)M * DM * 4;
constexpr size_t WS_ACT = WS_YBF;
constexpr size_t WS_MIX = WS_XB + (size_t)M * DM * 4;
constexpr size_t WS_KCV = WS_MIX + (size_t)M * DM * 2;
constexpr size_t WS_PQ = WS_KCV + (size_t)2 * 16 * T * 128 * 2;
constexpr size_t WS_KCMP = WS_PQ + (size_t)4 * 4096 * 1024 * 4;
constexpr size_t WS_VCMP = WS_KCMP + (size_t)16 * 128 * 128 * 2;
constexpr size_t WS_SEL = WS_VCMP + (size_t)16 * 128 * 128 * 2;
constexpr size_t WS_OCMP = WS_SEL + (size_t)16 * T * 4;
constexpr size_t WS_OSLC = WS_OCMP + (size_t)M * 2048 * 4;
constexpr size_t WS_OAB = WS_OSLC + (size_t)M * 2048 * 4;
constexpr int NUNIT = NB * 8 * NCHUNK;
constexpr size_t WS_G_UT = WS_OAB + (size_t)M * 2048 * 4;
constexpr size_t WS_G_W = WS_G_UT + (size_t)NUNIT * 128 * 64 * 4;
constexpr size_t WS_G_QD = WS_G_W + (size_t)NUNIT * 64 * 128 * 2;
constexpr size_t WS_G_KDT = WS_G_QD + (size_t)NUNIT * 64 * 128 * 2;
constexpr size_t WS_G_QK = WS_G_KDT + (size_t)NUNIT * 64 * 128 * 2;
constexpr size_t WS_G_DL = WS_G_QK + (size_t)NUNIT * 64 * 64 * 2;
constexpr size_t WS_H_QD = al256(WS_G_DL + (size_t)NUNIT * 4);
constexpr size_t WS_H_KDT = WS_H_QD + (size_t)NUNIT * 64 * 128 * 2;
constexpr size_t WS_H_ATT = WS_H_KDT + (size_t)NUNIT * 64 * 128 * 2;
constexpr size_t WS_H_VT = WS_H_ATT + (size_t)NUNIT * 64 * 64 * 2;
constexpr size_t WS_H_DEC = WS_H_VT + (size_t)NUNIT * 64 * 128 * 2;
constexpr size_t WS_WIN2 = al256(WS_H_DEC + (size_t)NUNIT * 128 * 4);
constexpr size_t WS_END = al256(WS_WIN2 + (size_t)NINP * DM * 2);
static_assert((size_t)M * FF * 2 <= (size_t)M * LDY * 2, "ACT overlay fits in Ybf");
static_assert(WS_END <= 1780000000ull, "workspace budget (ws_size >= sum of inputs = 1.806 GB)");
constexpr int CW_BAR = 4096;

#define WS_WIN_L(l) (((l) & 1) ? WS_WIN2 : WS_WIN)
constexpr int LDS_BYTES = 147456;
constexpr int MISC_OFF = LDS_BYTES - 256;
constexpr int SCR_BYTES = MISC_OFF;

DI float bf2f(bf16_t v) { return __builtin_bit_cast(float, (unsigned)v << 16); }
DI float bflo(unsigned w) { return __builtin_bit_cast(float, w << 16); }
DI float bfhi(unsigned w) { return __builtin_bit_cast(float, w & 0xffff0000u); }
DI unsigned pk2(float lo, float hi) { f32x2 v = {lo, hi}; bf16x2_t r = __builtin_convertvector(v, bf16x2_t); return __builtin_bit_cast(unsigned, r); }
DI bf16_t f2bf(float f) { return (bf16_t)(pk2(f, 0.f) & 0xffffu); }
DI float sigmoid_f(float x) { return __builtin_amdgcn_rcpf(1.0f + __expf(-x)); }
DI float silu_f(float x) { return x * __builtin_amdgcn_rcpf(1.0f + __expf(-x)); }
DI float softplus_f(float x) { return fmaxf(x, 0.f) + log1pf(__expf(-fabsf(x))); }
#define DPP_F(v, ctrl) __builtin_bit_cast(float, __builtin_amdgcn_mov_dpp(__builtin_bit_cast(int, (v)), (ctrl), 0xF, 0xF, true))
DI float row16_sum(float v) {
    v += DPP_F(v, 0xB1); v += DPP_F(v, 0x4E); v += DPP_F(v, 0x141); v += DPP_F(v, 0x140); return v;
}
DI int lane_id_fresh() { unsigned z = 0u; asm volatile("" : "+s"(z)); return (int)__builtin_amdgcn_mbcnt_hi(~0u, __builtin_amdgcn_mbcnt_lo(~0u, z)); }
DI int sh_bperm(int idx, int v) { return __builtin_amdgcn_ds_bpermute(idx << 2, v); }
DI float my_shfl_xor(float v, int m) { return __builtin_bit_cast(float, sh_bperm((lane_id_fresh() ^ m) & 63, __builtin_bit_cast(int, v))); }
DI unsigned my_shfl_xor(unsigned v, int m) { return (unsigned)sh_bperm((lane_id_fresh() ^ m) & 63, (int)v); }
DI float my_shfl_up(float v, int d) { const int l = lane_id_fresh(); return __builtin_bit_cast(float, sh_bperm(l >= d ? l - d : l, __builtin_bit_cast(int, v))); }
DI float my_shfl(float v, int s) { return __builtin_bit_cast(float, sh_bperm(s & 63, __builtin_bit_cast(int, v))); }
#define __shfl_xor my_shfl_xor
#define __shfl_up my_shfl_up
#define __shfl my_shfl
DI float xhalf_max(float v) { const auto rr = __builtin_amdgcn_permlane32_swap(__float_as_uint(v), __float_as_uint(v), false, false); return fmaxf(__uint_as_float(rr[0]), __uint_as_float(rr[1])); }
DI float xhalf_sum(float v) { const auto rr = __builtin_amdgcn_permlane32_swap(__float_as_uint(v), __float_as_uint(v), false, false); return __uint_as_float(rr[0]) + __uint_as_float(rr[1]); }
DI float wave_sum(float v) { v = row16_sum(v); v += __shfl_xor(v, 16); v += __shfl_xor(v, 32); return v; }
DI float half_sum(float v) { v = row16_sum(v); v += __shfl_xor(v, 16); return v; }
DI s16x4 tr_read(const LAS void* p) { return __builtin_bit_cast(s16x4, __builtin_amdgcn_ds_read_tr16_b64_v4i16((LAS v4i16_t*)p)); }
DI f32x16 mfma32(bf16x8 a, bf16x8 b, f32x16 c) { return __builtin_amdgcn_mfma_f32_32x32x16_bf16(a, b, c, 0, 0, 0); }
DI f32x4 mfma16(bf16x8 a, bf16x8 b, f32x4 c) { return __builtin_amdgcn_mfma_f32_16x16x32_bf16(a, b, c, 0, 0, 0); }
DI f32x16 zero16() { f32x16 z; for (int i = 0; i < 16; ++i) z[i] = 0.f; return z; }

struct Ctx {
    LAS unsigned char* lds;
    int tid, lane, wave, G, vcu;
    const float* const __attribute__((address_space(4)))* kin;
    GAS float* out; GAS unsigned char* ws;
};
DI int src_col_in(int r) {
    if (r < 1024) return r;
    if (r < 2048) return 2048 + (r - 1024);
    if (r < 3072) return 3072 + (r - 2048);
    if (r < 7168) return 4096 + (r - 3072);
    if (r < 9216) return 8208 + (r - 7168);
    if (r < 12288) return 10256 + (r - 9216);
    const int q = r - 12288;
    if (q < 1024) return 1024 + q;
    if (q < 1032) return 8192 + (q - 1024);
    if (q < 1040) return 8200 + (q - 1032);
    if (q < 1088) return 13328 + (q - 1040);
    return -1;
}
constexpr int P0_NG[5] = {8, 8, 8, (FF / 64 + 7) / 8, 4};
constexpr int P0_NI[5] = {8 * (NINP / 64), 8 * 64, 8 * (2 * FF / 64), ((FF / 64 + 7) / 8) * 64, 64};
struct P0Addr { const float* src; bf16_t* dst; float keep; };
template <int MAT> DI P0Addr p0_addr(const Ctx& C, int l, int q, int wave, int lane) {
    constexpr int NG = P0_NG[MAT];
    const int n4 = 4 * (lane & 15), kr0 = 64 * wave + 16 * (lane >> 4); P0Addr a; a.keep = 1.0f;
    if (MAT == 0) { const int g = q % NG, nb = q / NG; const int sc = src_col_in(nb * 64 + n4); a.keep = sc >= 0 ? 1.0f : 0.0f;
        a.src = C.kin[IN_W_IN] + (size_t)l * DM * NIN + (size_t)(g * 512 + kr0) * NIN + (sc < 0 ? 0 : sc); a.dst = (bf16_t*)(C.ws + WS_WIN_L(l)) + (size_t)(nb * 64 + 8 * wave) * DM + g * 512 + 8 * lane; }
    else if (MAT == 1) { const int g = q % NG, nb = q / NG;
        a.src = C.kin[IN_W_OUT] + (size_t)l * DM * DM + (size_t)(g * 512 + kr0) * DM + nb * 64 + n4; a.dst = (bf16_t*)(C.ws + WS_WOUT) + (size_t)(nb * 64 + 8 * wave) * DM + g * 512 + 8 * lane; }
    else if (MAT == 2) { const int g = q % NG, nb = q / NG; const int n = nb * 64 + n4, p = n >> 8, within = n & 255;
        const float* base = (within >> 7) ? C.kin[IN_W_UP] : C.kin[IN_W_GATE];
        a.src = base + (size_t)l * DM * FF + (size_t)(g * 512 + kr0) * FF + p * 128 + (within & 127); a.dst = (bf16_t*)(C.ws + WS_WGU) + (size_t)(nb * 64 + 8 * wave) * DM + g * 512 + 8 * lane; }
    else if (MAT == 3) { const int g = q % NG, nb = q / NG; const bool part = (g == NG - 1);
        const int kr = part ? (kr0 & 255) : kr0, kl = part ? (8 * lane) & 255 : 8 * lane;
        a.src = C.kin[IN_W_DOWN] + (size_t)l * FF * DM + (size_t)(g * 512 + kr) * DM + nb * 64 + n4; a.dst = (bf16_t*)(C.ws + WS_WD) + (size_t)(nb * 64 + 8 * wave) * FF + g * 512 + kl; }
    else { const int mi = q >> 4, kv = mi >> 1, half = mi & 1, g = q & 3, nb = (q >> 2) & 3;
        const float* w1 = (kv ? C.kin[IN_W1_V] : C.kin[IN_W1_K]) + (size_t)l * 4096 * 256 + (size_t)half * 2048 * 256;
        a.src = w1 + (size_t)(g * 512 + kr0) * 256 + nb * 64 + n4; a.dst = (bf16_t*)(C.ws + WS_W1CAT) + ((size_t)kv * 512 + half * 256 + nb * 64 + 8 * wave) * 2048 + g * 512 + 8 * lane; }
    return a;
}
constexpr int P0_FILL_DN2 = 288;
constexpr int P0_AHEAD_A = 1000, P0_AHEAD_B = 1696;
constexpr int P0_LAST_GU = 1000;
constexpr int P0_FILL_DN = 512;
template <int MAT, int MODE> DI void p0_mat(const Ctx& C, int l, int qb, int qe, int first, int stride, int& par) {
    constexpr int TP = 516;
    constexpr size_t LDS_ = (MAT == 0) ? NIN : (MAT == 2) ? FF : (MAT == 4) ? 256 : DM;
    constexpr size_t LDD_ = (MAT == 3) ? FF : (MAT == 4) ? 2048 : DM;
    LAS bf16_t* tb0 = (LAS bf16_t*)C.lds; LAS bf16_t* tb1 = tb0 + 64 * TP;
    const int lane = C.lane, wave = C.wave, G = C.G;
    int q = qb + first; (void)G;
    if (q >= qe) return;
    P0Addr cur = p0_addr<MAT>(C, l, q, wave, lane);
    f32x4 vn[16];
#pragma unroll
    for (int i = 0; i < 16; ++i) vn[i] = (MODE != 2) ? __builtin_nontemporal_load((const f32x4*)(cur.src + (size_t)i * LDS_)) : (f32x4){1.f, 2.f, 3.f, 4.f};
    for (; q < qe; q += stride) {
        f32x4 v[16];
#pragma unroll
        for (int i = 0; i < 16; ++i) v[i] = vn[i] * cur.keep;
        if (MAT == 0 || MAT == 2) {
            const float* nw = C.kin[MAT == 0 ? IN_ATTN_NORM : IN_FFN_NORM] + (size_t)l * DM + (q % P0_NG[MAT]) * 512 + 64 * wave + 16 * (lane >> 4);
#pragma unroll
            for (int i4 = 0; i4 < 4; ++i4) { const f32x4 w4 = *(const f32x4*)(nw + 4 * i4); v[4 * i4] = v[4 * i4] * w4[0]; v[4 * i4 + 1] = v[4 * i4 + 1] * w4[1]; v[4 * i4 + 2] = v[4 * i4 + 2] * w4[2]; v[4 * i4 + 3] = v[4 * i4 + 3] * w4[3]; } }
        const int qn = (q + stride < qe) ? q + stride : q; const P0Addr nxt = p0_addr<MAT>(C, l, qn, wave, lane);
        if (MODE != 2) {
#pragma unroll
            for (int i = 0; i < 16; ++i) vn[i] = __builtin_nontemporal_load((const f32x4*)(nxt.src + (size_t)i * LDS_)); }
        LAS bf16_t* tb = par ? tb1 : tb0;
        { const int m = lane & 15, kl = 64 * wave + 16 * (lane >> 4);
#pragma unroll
          for (int kk = 0; kk < 4; ++kk)
#pragma unroll
              for (int j = 0; j < 4; ++j) { u32x2 o; o.x = pk2(v[4 * kk][j], v[4 * kk + 1][j]); o.y = pk2(v[4 * kk + 2][j], v[4 * kk + 3][j]);
                  *(LAS u32x2*)(tb + (4 * m + j) * TP + kl + 4 * kk) = o; } }
        asm volatile("s_waitcnt lgkmcnt(0)" ::: "memory"); __builtin_amdgcn_s_barrier(); asm volatile("" ::: "memory");
        { const int kl = (MAT == 3 && (q % P0_NG[MAT]) == P0_NG[MAT] - 1) ? (8 * lane) & 255 : 8 * lane;
#pragma unroll
          for (int rr = 0; rr < 8; ++rr) { const LAS u32x2* sp = (const LAS u32x2*)(tb + (8 * wave + rr) * TP + kl); const u32x2 a = sp[0], b2 = sp[1];
              u32x4 o; o.x = a.x; o.y = a.y; o.z = b2.x; o.w = b2.y;
              if (MODE != 1) *(u32x4*)(cur.dst + (size_t)rr * LDD_) = o; else asm volatile("" :: "v"(o)); } }
        cur = nxt; par ^= 1;
    }
}
template <int MAT> DI void p0_mat2(const Ctx& C, int l, int qb, int qe, int first, int stride, int& par) {
    constexpr int TP = 516;
    constexpr size_t LDS_ = (MAT == 0) ? NIN : (MAT == 2) ? FF : (MAT == 4) ? 256 : DM;
    constexpr size_t LDD_ = (MAT == 3) ? FF : (MAT == 4) ? 2048 : DM;
    LAS bf16_t* tb0 = (LAS bf16_t*)C.lds; LAS bf16_t* tb1 = tb0 + 64 * TP;
    const int lane = C.lane, wave = C.wave;
    int q = qb + first;
    if (q >= qe) return;
    LAS float* nwl = (LAS float*)(C.lds + 2 * 64 * TP * 2);
    if (MAT == 0 || MAT == 2) { const float* nw = C.kin[MAT == 0 ? IN_ATTN_NORM : IN_FFN_NORM] + (size_t)l * DM + (q % P0_NG[MAT]) * 512;
        nwl[C.tid] = nw[C.tid]; asm volatile("s_waitcnt vmcnt(0) lgkmcnt(0)" ::: "memory"); __builtin_amdgcn_s_barrier(); asm volatile("" ::: "memory"); }
    P0Addr a0 = p0_addr<MAT>(C, l, q, wave, lane), a1 = p0_addr<MAT>(C, l, (q + stride < qe) ? q + stride : q, wave, lane);
    f32x4 SA[16], SB[16];
#pragma unroll
    for (int i = 0; i < 16; ++i) SA[i] = __builtin_nontemporal_load((const f32x4*)(a0.src + (size_t)i * LDS_));
#pragma unroll
    for (int i = 0; i < 16; ++i) SB[i] = __builtin_nontemporal_load((const f32x4*)(a1.src + (size_t)i * LDS_));
#define P0_PROCESS(S, cur, qq, nxt) do { \
        f32x4 v[16]; \
        _Pragma("unroll") for (int i = 0; i < 16; ++i) v[i] = S[i] * cur.keep; \
        if (MAT == 0 || MAT == 2) { \
            const LAS float* nwp = nwl + 64 * wave + 16 * (lane >> 4); \
            _Pragma("unroll") for (int i4 = 0; i4 < 4; ++i4) { const f32x4 w4 = *(const LAS f32x4*)(nwp + 4 * i4); v[4 * i4] = v[4 * i4] * w4[0]; v[4 * i4 + 1] = v[4 * i4 + 1] * w4[1]; v[4 * i4 + 2] = v[4 * i4 + 2] * w4[2]; v[4 * i4 + 3] = v[4 * i4 + 3] * w4[3]; } } \
        _Pragma("unroll") for (int i = 0; i < 16; ++i) S[i] = __builtin_nontemporal_load((const f32x4*)(nxt.src + (size_t)i * LDS_)); \
        LAS bf16_t* tb = par ? tb1 : tb0; \
        { const int m = lane & 15, kl = 64 * wave + 16 * (lane >> 4); \
          _Pragma("unroll") for (int kk = 0; kk < 4; ++kk) \
              _Pragma("unroll") for (int j = 0; j < 4; ++j) { u32x2 o; o.x = pk2(v[4 * kk][j], v[4 * kk + 1][j]); o.y = pk2(v[4 * kk + 2][j], v[4 * kk + 3][j]); \
                  *(LAS u32x2*)(tb + (4 * m + j) * TP + kl + 4 * kk) = o; } } \
        asm volatile("s_waitcnt lgkmcnt(0)" ::: "memory"); __builtin_amdgcn_s_barrier(); asm volatile("" ::: "memory"); \
        { const int kl = (MAT == 3 && ((qq) % P0_NG[MAT]) == P0_NG[MAT] - 1) ? (8 * lane) & 255 : 8 * lane; \
          _Pragma("unroll") for (int rr = 0; rr < 8; ++rr) { const LAS u32x2* sp = (const LAS u32x2*)(tb + (8 * wave + rr) * TP + kl); const u32x2 a = sp[0], b2 = sp[1]; \
              u32x4 o; o.x = a.x; o.y = a.y; o.z = b2.x; o.w = b2.y; \
              *(u32x4*)(cur.dst + (size_t)rr * LDD_) = o; } } \
        par ^= 1; } while (0)
    for (; q < qe; q += 2 * stride) {
        const P0Addr a2 = p0_addr<MAT>(C, l, (q + 2 * stride < qe) ? q + 2 * stride : q, wave, lane);
        P0_PROCESS(SA, a0, q, a2);
        if (q + stride >= qe) break;
        const P0Addr a3 = p0_addr<MAT>(C, l, (q + 3 * stride < qe) ? q + 3 * stride : q, wave, lane);
        P0_PROCESS(SB, a1, q + stride, a3);
        a0 = a2; a1 = a3;
    }
#undef P0_PROCESS
}
DI void phase_tables(const Ctx& C) {
    float* cosT = (float*)(C.ws + WS_ROPE_C); float* sinT = (float*)(C.ws + WS_ROPE_S);
    for (int idx = C.vcu * 512 + C.tid; idx < T * 64; idx += C.G * 512) { const int t = idx >> 6, i = idx & 63;
        const float inv = (float)pow(10000.0, -(double)(2 * i) / 128.0); const float ang = (float)t * inv;
        cosT[idx] = (float)cos((double)ang); sinT[idx] = (float)sin((double)ang); }
}
template <int MODE> DI void phase_p0_t(const Ctx& C, int l) {
    const int lane = C.lane, gw = C.vcu * 8 + C.wave, NGW = C.G * 8; int par = 0;
    const bool fill = (C.G == 256); const int G = C.G; int B = 0;
#define P0_RANGE(MAT, qb, qe) do { p0_mat<MAT, MODE>(C, l, qb, qe, ((C.vcu - B) % G + G) % G, G, par); B += (qe) - (qb); } while (0)
    P0_RANGE(0, ((fill && l > 0) ? P0_AHEAD_B : 0), P0_NI[0]);
    if (!fill) P0_RANGE(1, 0, P0_NI[1]);
    const bool last = fill && (l + 1 == DEPTH);
    P0_RANGE(2, (last ? P0_LAST_GU : 0), P0_NI[2]);
    if (!last) P0_RANGE(3, (fill ? P0_FILL_DN + P0_FILL_DN2 : 0), P0_NI[3]);
    P0_RANGE(4, 0, P0_NI[4]);
#undef P0_RANGE
    asm volatile("s_waitcnt lgkmcnt(0)" ::: "memory"); __builtin_amdgcn_s_barrier(); asm volatile("" ::: "memory");
    if (MODE != 0) return;
    { bf16_t* W2T = (bf16_t*)(C.ws + WS_W2T);
      for (int t = C.vcu * 512 + C.tid; t < 2 * 128 * 32; t += C.G * 512) { const int kv = t >> 12, d = t & 127, k0 = ((t >> 7) & 31) * 8;
          const float* w2 = (kv ? C.kin[IN_W2_V] : C.kin[IN_W2_K]) + (size_t)l * 256 * 128 + (size_t)k0 * 128 + d;
          u32x4 o; o.x = pk2(w2[0], w2[128]); o.y = pk2(w2[256], w2[384]); o.z = pk2(w2[512], w2[640]); o.w = pk2(w2[768], w2[896]);
          *(u32x4*)(W2T + ((size_t)kv * 128 + d) * 256 + k0) = o; } }
    { const int t = C.G - 1 - C.vcu;
      if (t < 16) { const int kv = t >> 3, rng = t & 7, wave = C.wave;
          const float* pos = (kv ? C.kin[IN_POS_V] : C.kin[IN_POS_K]) + (size_t)l * 4096 + rng * 512 + wave * 64;
          const float* w1 = (kv ? C.kin[IN_W1_V] : C.kin[IN_W1_K]) + (size_t)l * 4096 * 256 + (size_t)(rng * 512 + wave * 64) * 256 + 4 * lane;
          f32x4 acc = {0.f, 0.f, 0.f, 0.f};
#pragma unroll 16
          for (int i = 0; i < 64; ++i) acc += pos[i] * *(const f32x4*)(w1 + (size_t)i * 256);
          LAS float* red = (LAS float*)C.lds;
          *(LAS f32x4*)(red + wave * 256 + 4 * lane) = acc;
          __syncthreads();
          if (C.tid < 256) { float sum = 0.f;
#pragma unroll
              for (int w = 0; w < 8; ++w) sum += red[w * 256 + C.tid];
              ((float*)(C.ws + WS_C1))[(kv * 8 + rng) * 256 + C.tid] = sum; }
          __syncthreads(); } }
    (void)gw; (void)NGW;
}
DI void phase_p0(const Ctx& C, int l) { phase_p0_t<0>(C, l); }
constexpr int P0_NDED = 8, P0_DED_X = 400;
DI void p0_fill_in_ded(const Ctx& C, int l, int f, int F) { int par = 0; p0_mat2<1>(C, l, 0, P0_NI[1], f, F, par); p0_mat2<3>(C, l, P0_FILL_DN, P0_FILL_DN + P0_FILL_DN2, f, F, par);
    if (l + 1 < DEPTH) p0_mat2<0>(C, l + 1, 0, P0_DED_X, f, F, par); else p0_mat2<2>(C, l, 0, P0_DED_X, f, F, par);
    asm volatile("s_waitcnt lgkmcnt(0)" ::: "memory"); __builtin_amdgcn_s_barrier(); asm volatile("" ::: "memory"); }
DI void p0_fill_in_tail(const Ctx& C, int l, int f, int F) { int par = 0;
    if (l + 1 < DEPTH) p0_mat2<0>(C, l + 1, P0_DED_X, P0_AHEAD_A, f, F, par); else p0_mat2<2>(C, l, P0_DED_X, P0_LAST_GU, f, F, par);
    asm volatile("s_waitcnt lgkmcnt(0)" ::: "memory"); __builtin_amdgcn_s_barrier(); asm volatile("" ::: "memory"); }
DI void p0_fill_wdown(const Ctx& C, int l, int f, int F) { int par = 0; p0_mat2<3>(C, l, 0, P0_FILL_DN, f, F, par); if (l + 1 < DEPTH) p0_mat2<0>(C, l + 1, P0_AHEAD_A, P0_AHEAD_B, f, F, par); else p0_mat2<3>(C, l, P0_FILL_DN + P0_FILL_DN2, P0_NI[3], f, F, par); asm volatile("s_waitcnt lgkmcnt(0)" ::: "memory"); __builtin_amdgcn_s_barrier(); asm volatile("" ::: "memory"); }
DI void phase_xcvt(const Ctx& C, const float* x, bf16_t* outb, unsigned long long* rs) {
    const int gw = C.vcu * 8 + C.wave, NGW = C.G * 8, lane = C.lane;
    for (int row = gw; row < M; row += NGW) {
        const f32x4* xr = (const f32x4*)(x + (size_t)row * DM) + lane; float s = 0.f;
#pragma unroll
        for (int j = 0; j < 16; ++j) { const f32x4 v = xr[64 * j]; s += (v[0] * v[0] + v[1] * v[1]) + (v[2] * v[2] + v[3] * v[3]);
            u32x2 o; o.x = pk2(v[0], v[1]); o.y = pk2(v[2], v[3]); *(u32x2*)(outb + (size_t)row * DM + 4 * (lane + 64 * j)) = o; }
        s = wave_sum(s); if (lane == 0) rs[row] = (unsigned long long)(s * 1048576.0f + 0.5f);
    }
}
DI void phase_final_norm(const Ctx& C, const bf16_t* x, const float* w, float* outf) {
    const int gw = C.vcu * 8 + C.wave, NGW = C.G * 8, lane = C.lane;
    for (int row = gw; row < M; row += NGW) {
        const u32x4* xr = (const u32x4*)(x + (size_t)row * DM) + lane;
        float v[8][8]; float s = 0.f;
#pragma unroll
        for (int j = 0; j < 8; ++j) { const u32x4 q = xr[64 * j]; v[j][0] = bflo(q.x); v[j][1] = bfhi(q.x); v[j][2] = bflo(q.y); v[j][3] = bfhi(q.y); v[j][4] = bflo(q.z); v[j][5] = bfhi(q.z); v[j][6] = bflo(q.w); v[j][7] = bfhi(q.w);
#pragma unroll
            for (int e = 0; e < 8; ++e) s += v[j][e] * v[j][e]; }
        const float r = 1.0f / sqrtf(wave_sum(s) * (1.0f / DM) + NORM_EPS);
#pragma unroll
        for (int j = 0; j < 8; ++j) { const size_t c0 = (size_t)8 * (lane + 64 * j); const f32x4 w0 = *(const f32x4*)(w + c0), w1 = *(const f32x4*)(w + c0 + 4);
            *(f32x4*)(outf + (size_t)row * DM + c0) = (f32x4){v[j][0] * r * w0[0], v[j][1] * r * w0[1], v[j][2] * r * w0[2], v[j][3] * r * w0[3]};
            *(f32x4*)(outf + (size_t)row * DM + c0 + 4) = (f32x4){v[j][4] * r * w1[0], v[j][5] * r * w1[1], v[j][6] * r * w1[2], v[j][7] * r * w1[3]}; }
    }
}
template <bool BF> DI void phase_rmsnorm(const Ctx& C, const float* x, const float* w, bf16_t* outb, float* outf) {
    const int gw = C.vcu * 8 + C.wave, NGW = C.G * 8, lane = C.lane;
    for (int row = gw; row < M; row += NGW) {
        const f32x4* xr = (const f32x4*)(x + (size_t)row * DM) + lane;
        f32x4 v[16]; float s = 0.f;
#pragma unroll
        for (int j = 0; j < 16; ++j) { v[j] = xr[64 * j]; s += (v[j][0] * v[j][0] + v[j][1] * v[j][1]) + (v[j][2] * v[j][2] + v[j][3] * v[j][3]); }
        const float r = 1.0f / sqrtf(wave_sum(s) * (1.0f / DM) + NORM_EPS);
#pragma unroll
        for (int j = 0; j < 16; ++j) { const f32x4 wv = ((const f32x4*)w)[lane + 64 * j]; const f32x4 y = v[j] * r * wv;
            if (BF) { u32x2 o; o.x = pk2(y[0], y[1]); o.y = pk2(y[2], y[3]); *(u32x2*)(outb + (size_t)row * DM + 4 * (lane + 64 * j)) = o; }
            else *((f32x4*)(outf + (size_t)row * DM) + lane + 64 * j) = y; }
    }
}
DI void phase_rope(const Ctx& C, float sgn = 1.0f) {
    const int gw = C.vcu * 8 + C.wave, NGW = C.G * 8, lane = C.lane;
    bf16_t* Ybf = (bf16_t*)(C.ws + WS_YBF); bf16_t* KCV = (bf16_t*)(C.ws + WS_KCV);
    const float* cosT = (const float*)(C.ws + WS_ROPE_C); const float* sinT = (const float*)(C.ws + WS_ROPE_S);
    { unsigned long long* rsa = (unsigned long long*)(C.ws + WS_RSA); unsigned long long* rsb = (unsigned long long*)(C.ws + WS_RSB);
      for (int i = C.vcu * 512 + C.tid; i < M; i += C.G * 512) { rsa[i] = 0ull; rsb[i] = 0ull; } }
    const int hs = lane >> 5, p2 = 2 * (lane & 31);
    for (int row = gw; row < M; row += NGW) {
        const int b = row / T, t = row - b * T;
        const f32x2 cs = *(const f32x2*)(cosT + t * 64 + p2), sn = *(const f32x2*)(sinT + t * 64 + p2) * sgn;
        bf16_t* yr = Ybf + (size_t)row * LDY;
#pragma unroll
        for (int i = 8; i < 14; ++i) { const int hv = 2 * i + hs;
            int col; if (hv < 16) col = Y_NQ + hv * 128; else if (hv < 20) col = Y_KC + (hv - 16) * 128; else if (hv < 24) col = Y_KS + (hv - 20) * 128; else col = Y_KW + (hv - 24) * 128;
            const unsigned a = *(const unsigned*)(yr + col + p2), bb = *(const unsigned*)(yr + col + 64 + p2);
            const float x1a = bflo(a), x1b = bfhi(a), x2a = bflo(bb), x2b = bfhi(bb);
            const unsigned o1 = pk2(x1a * cs[0] - x2a * sn[0], x1b * cs[1] - x2b * sn[1]), o2 = pk2(x2a * cs[0] + x1a * sn[0], x2b * cs[1] + x1b * sn[1]);
            bf16_t* dst = yr + col;
            if (hv >= 16 && hv < 20) dst = KCV + ((size_t)(b * 4 + (hv - 16)) * T + t) * 128;
            *(unsigned*)(dst + p2) = o1; *(unsigned*)(dst + 64 + p2) = o2; }
        { const u32x4 v = *(const u32x4*)(yr + Y_VC + lane * 8); const int g = lane >> 4, d = (lane & 15) * 8;
            *(u32x4*)(KCV + ((size_t)(16 + b * 4 + g) * T + t) * 128 + d) = v; }
    }
}
DI void hgrn_pre_unit(const Ctx& C, int l, int u) {
    const int tid = C.tid, lane = C.lane, wave = C.wave;
    const int b = u >> 8, h = (u >> 5) & 7, c = u & 31, row0 = b * T + 64 * c;
    const bf16_t* Ybf = (const bf16_t*)(C.ws + WS_YBF); const float* Yf = (const float*)(C.ws + WS_YF);
    LAS float* Bc = (LAS float*)(C.lds);
    LAS float* Kf = (LAS float*)(C.lds + 32768);
    LAS bf16_t* Qt = (LAS bf16_t*)(C.lds + 65536);
    LAS bf16_t* Kt = (LAS bf16_t*)(C.lds + 82944);
    bf16_t* HQD = (bf16_t*)(C.ws + WS_H_QD) + (size_t)u * 8192; bf16_t* HKDT = (bf16_t*)(C.ws + WS_H_KDT) + (size_t)u * 8192;
    bf16_t* HATT = (bf16_t*)(C.ws + WS_H_ATT) + (size_t)u * 4096; bf16_t* HVT = (bf16_t*)(C.ws + WS_H_VT) + (size_t)u * 8192; float* HDEC = (float*)(C.ws + WS_H_DEC) + (size_t)u * 128;
    { const int d = tid & 127, seg = tid >> 7; float lb = 0.f;
      LAS float* segtot = (LAS float*)(C.lds + 117760);
      if (l == 1) { const float x0 = C.kin[IN_LB][h * 128 + d], x1 = C.kin[IN_LB][1024 + h * 128 + d]; lb = 1.0f / (1.0f + __expf(x1 - x0)); }
      float fpv[16];
#pragma unroll
      for (int i = 0; i < 16; ++i) fpv[i] = Yf[(size_t)(row0 + 16 * seg + i) * LDF + F_HF + h * 128 + d];
      float pre[16]; float run = 0.f;
#pragma unroll
      for (int i = 0; i < 16; ++i) { const float fp = fpv[i];
          const float e = __expf(-fabsf(fp)); const float r = 1.0f / (1.0f + e); const float sp = (fp >= 0.f) ? r : e * r, sm = (fp >= 0.f) ? e * r : r;
          const float kf = (1.0f - lb) * sm, f = lb + (1.0f - lb) * sp;
          const float lf = (kf < 0.125f) ? -kf * (1.0f + kf * (0.5f + kf * (0.33333334f + kf * (0.25f + kf * (0.2f + kf * 0.16666667f))))) : __logf(fmaxf(f, 1e-38f));
          run += fminf(lf, 0.f); pre[i] = run; Kf[(16 * seg + i) * 128 + d] = kf; }
      segtot[seg * 128 + d] = run;
      __syncthreads();
      float off = 0.f;
#pragma unroll
      for (int s2 = 0; s2 < 3; ++s2) off += (s2 < seg) ? segtot[s2 * 128 + d] : 0.f;
#pragma unroll
      for (int i = 0; i < 16; ++i) Bc[(16 * seg + i) * 128 + d] = pre[i] + off; }
    __syncthreads();
#pragma unroll
    for (int i = 0; i < 2; ++i) { const int task = tid + 512 * i, s = task >> 4, d0 = (task & 15) * 8;
        const u32x4 qw = *(const u32x4*)(Ybf + (size_t)(row0 + s) * LDY + Y_HQ + h * 128 + d0);
        float q[8]; q[0] = bflo(qw.x); q[1] = bfhi(qw.x); q[2] = bflo(qw.y); q[3] = bfhi(qw.y); q[4] = bflo(qw.z); q[5] = bfhi(qw.z); q[6] = bflo(qw.w); q[7] = bfhi(qw.w);
        float qd[8], qt[8], kt[8];
#pragma unroll
        for (int j = 0; j < 8; ++j) { const float qq = silu_f(q[j]); const float bb = Bc[s * 128 + d0 + j], bm = Bc[32 * 128 + d0 + j], kk = Kf[s * 128 + d0 + j];
            qd[j] = qq * __expf(bb); qt[j] = qq * __expf(fminf(bb - bm, 80.f)); kt[j] = kk * __expf(fminf(bm - bb, 80.f)); }
        u32x4 o; o.x = pk2(qd[0], qd[1]); o.y = pk2(qd[2], qd[3]); o.z = pk2(qd[4], qd[5]); o.w = pk2(qd[6], qd[7]);
        *(u32x4*)(HQD + s * 128 + d0) = o;
        o.x = pk2(qt[0], qt[1]); o.y = pk2(qt[2], qt[3]); o.z = pk2(qt[4], qt[5]); o.w = pk2(qt[6], qt[7]);
        *(LAS u32x4*)(Qt + s * 136 + d0) = o;
        o.x = pk2(kt[0], kt[1]); o.y = pk2(kt[2], kt[3]); o.z = pk2(kt[4], kt[5]); o.w = pk2(kt[6], kt[7]);
        *(LAS u32x4*)(Kt + s * 136 + d0) = o; }
#pragma unroll
    for (int i = 0; i < 2; ++i) { const int task = tid + 512 * i, d = task & 127, s0 = (task >> 7) * 8;
        const float bl = Bc[63 * 128 + d]; float kv[8], vv[8];
#pragma unroll
        for (int j = 0; j < 8; ++j) { kv[j] = Kf[(s0 + j) * 128 + d] * __expf(bl - Bc[(s0 + j) * 128 + d]); vv[j] = bf2f(Ybf[(size_t)(row0 + s0 + j) * LDY + Y_HI + h * 128 + d]); }
        u32x4 o; o.x = pk2(kv[0], kv[1]); o.y = pk2(kv[2], kv[3]); o.z = pk2(kv[4], kv[5]); o.w = pk2(kv[6], kv[7]);
        *(u32x4*)(HKDT + d * 64 + s0) = o;
        o.x = pk2(vv[0], vv[1]); o.y = pk2(vv[2], vv[3]); o.z = pk2(vv[4], vv[5]); o.w = pk2(vv[6], vv[7]);
        *(u32x4*)(HVT + d * 64 + s0) = o; }
    if (tid < 128) HDEC[tid] = __expf(Bc[63 * 128 + tid]);
    __syncthreads();
    if (wave < 4) { const int tt = wave >> 1, st = wave & 1, r31 = lane & 31, hh = lane >> 5;
        f32x16 acc = zero16();
#pragma unroll
        for (int ks = 0; ks < 8; ++ks) { const bf16x8 a = *(const LAS bf16x8*)(Qt + (32 * tt + r31) * 136 + 16 * ks + 8 * hh), bb = *(const LAS bf16x8*)(Kt + (32 * st + r31) * 136 + 16 * ks + 8 * hh);
            acc = mfma32(a, bb, acc); }
        const int s = 32 * st + r31;
#pragma unroll
        for (int r = 0; r < 16; ++r) { const int t = 32 * tt + (r & 3) + 8 * (r >> 2) + 4 * hh; const float v = (s <= t) ? acc[r] : 0.f; HATT[t * 64 + s] = f2bf(v); } }
    __syncthreads();
}
template <bool STORE> DI void gdn_solve(LAS float* RHS, LAS float* Mx, LAS bf16_t* KdT, float* GUT, bf16_t* GW, bf16_t* GKDT, int tid) {
    const int lane = tid & 63, wave = tid >> 6, r15 = lane & 15, kq = lane >> 4;
#pragma unroll
    for (int bi = 0; bi < 4; ++bi) {
        if (bi > 0) {
#pragma unroll
            for (int ct2 = 0; ct2 < 2; ++ct2) { const int ct = 2 * wave + ct2; f32x4 acc = {0.f, 0.f, 0.f, 0.f};
#pragma unroll
                for (int kk = 0; kk < 4 * bi; ++kk) acc = __builtin_amdgcn_mfma_f32_16x16x4f32(Mx[(4 * kk + kq) * 68 + 16 * bi + r15], RHS[(4 * kk + kq) * 256 + 16 * ct + r15], acc, 0, 0, 0);
#pragma unroll
                for (int r = 0; r < 4; ++r) RHS[(16 * bi + 4 * kq + r) * 256 + 16 * ct + r15] -= acc[r]; }
            __syncthreads();
        }
        if (tid < 256) {
            float s[16];
#pragma unroll
            for (int r = 0; r < 16; ++r) s[r] = RHS[(16 * bi + r) * 256 + tid];
#pragma unroll
            for (int j = 0; j < 16; ++j) { const float xj = s[j];
#pragma unroll
                for (int r4 = 0; r4 < 4; ++r4) { const f32x4 m = *(const LAS f32x4*)(Mx + (16 * bi + j) * 68 + 16 * bi + 4 * r4);
#pragma unroll
                    for (int e = 0; e < 4; ++e) if (4 * r4 + e > j) s[4 * r4 + e] -= m[e] * xj; } }
#pragma unroll
            for (int r = 0; r < 16; ++r) RHS[(16 * bi + r) * 256 + tid] = s[r];
            if (tid < 128) {
#pragma unroll
                for (int r4 = 0; r4 < 4; ++r4) if (STORE) *(f32x4*)(GUT + tid * 64 + 16 * bi + 4 * r4) = (f32x4){s[4 * r4], s[4 * r4 + 1], s[4 * r4 + 2], s[4 * r4 + 3]};
            } else {
#pragma unroll
                for (int r = 0; r < 16; ++r) if (STORE) GW[(16 * bi + r) * 128 + (tid - 128)] = f2bf(s[r]);
            }
        } else if (bi == 0) {
#pragma unroll
            for (int i = 0; i < 4; ++i) { const int task = (tid - 256) + 256 * i, d = task >> 3, s0 = (task & 7) * 8;
                if (STORE) *(u32x4*)(GKDT + d * 64 + s0) = *(const LAS u32x4*)(KdT + d * 72 + s0); }
        }
        if (bi < 3) __syncthreads();
    }
}
DI void gdn_pre_unit(const Ctx& C, int l, int u) {
    const int tid = C.tid, lane = C.lane, wave = C.wave;
    const int b = u >> 8, h = (u >> 5) & 7, c = u & 31, row0 = b * T + 64 * c;
    const bf16_t* Ybf = (const bf16_t*)(C.ws + WS_YBF); const float* Yf = (const float*)(C.ws + WS_YF);
    LAS float* RHS = (LAS float*)(C.lds);
    LAS float* Mx = (LAS float*)(C.lds + 65536);
    LAS bf16_t* Qs = (LAS bf16_t*)(C.lds + 82944);
    LAS bf16_t* Ks = (LAS bf16_t*)(C.lds + 100352);
    LAS bf16_t* KdT = (LAS bf16_t*)(C.lds + 117760);
    LAS float* gcL = (LAS float*)(C.lds + 136192);
    LAS float* betaL = gcL + 64; LAS float* egcL = gcL + 128;
    float* GUT = (float*)(C.ws + WS_G_UT) + (size_t)u * 8192; bf16_t* GW = (bf16_t*)(C.ws + WS_G_W) + (size_t)u * 8192; bf16_t* GQD = (bf16_t*)(C.ws + WS_G_QD) + (size_t)u * 8192;
    bf16_t* GKDT = (bf16_t*)(C.ws + WS_G_KDT) + (size_t)u * 8192; bf16_t* GQK = (bf16_t*)(C.ws + WS_G_QK) + (size_t)u * 4096; float* GDL = (float*)(C.ws + WS_G_DL);
    LAS float* CWL = (LAS float*)(C.lds + 137216);
    if (tid < 384) { const int sw = tid >> 5, sec = sw >> 2, w = sw & 3, dq = (tid & 31) * 4;
        *(LAS f32x4*)(CWL + sw * 128 + dq) = *(const f32x4*)(C.kin[IN_CONV] + (size_t)l * 4 * 3072 + w * 3072 + sec * 1024 + h * 128 + dq); }
    float gc_r, beta_r, egc_r, glast;
    { const float* alp = C.kin[IN_ALOG]; const float* dtp = C.kin[IN_DTB];
      const float a_raw = Yf[(size_t)(row0 + lane) * LDF + F_GA + h], b_raw = Yf[(size_t)(row0 + lane) * LDF + F_GB + h], alog = alp[l * 8 + h], dtb = dtp[l * 8 + h];
      float g = -__expf(alog) * softplus_f(a_raw + dtb);
#pragma unroll
      for (int o = 1; o < 64; o <<= 1) { const float t = __shfl_up(g, o); if (lane >= o) g += t; }
      gc_r = g; beta_r = sigmoid_f(b_raw); egc_r = __expf(g); glast = __shfl(g, 63);
      if (wave == 0) { gcL[lane] = g; betaL[lane] = beta_r; egcL[lane] = egc_r; if (lane == 63) GDL[u] = egc_r; } }
    __syncthreads();
    { const int hw = tid >> 5, sub = tid & 31, d0 = 4 * sub;
      const LAS float* cwl = CWL + d0;
      u32x2 xn[3][4];
#define GDN_LOADROW(dst, s_) do { _Pragma("unroll") for (int sec = 0; sec < 3; ++sec) _Pragma("unroll") for (int w = 0; w < 4; ++w) { const int ts = 64 * c + (s_) - 3 + w; \
              dst[sec][w] = *(const u32x2*)(Ybf + (size_t)(b * T + (ts < 0 ? 0 : ts)) * LDY + Y_GQ + sec * 1024 + h * 128 + d0); } } while (0)
      GDN_LOADROW(xn, hw);
#pragma unroll
      for (int i = 0; i < 4; ++i) { const int s = i * 16 + hw;
          u32x2 xw[3][4];
#pragma unroll
          for (int sec = 0; sec < 3; ++sec)
#pragma unroll
              for (int w = 0; w < 4; ++w) { const bool in = (64 * c + s - 3 + w) >= 0; xw[sec][w].x = in ? xn[sec][w].x : 0u; xw[sec][w].y = in ? xn[sec][w].y : 0u; }
          if (i < 3) GDN_LOADROW(xn, s + 16);
          const float bs = __shfl(beta_r, s), eg = __shfl(egc_r, s), f2 = __expf(glast - __shfl(gc_r, s));
#pragma unroll
          for (int sec = 0; sec < 3; ++sec) { float y[4] = {0.f, 0.f, 0.f, 0.f};
#pragma unroll
              for (int w = 0; w < 4; ++w) { const f32x4 cw = *(const LAS f32x4*)(cwl + (sec * 4 + w) * 128);
                  y[0] += bflo(xw[sec][w].x) * cw[0]; y[1] += bfhi(xw[sec][w].x) * cw[1]; y[2] += bflo(xw[sec][w].y) * cw[2]; y[3] += bfhi(xw[sec][w].y) * cw[3]; }
#pragma unroll
              for (int j = 0; j < 4; ++j) y[j] = silu_f(y[j]);
              if (sec < 2) { const float ss = half_sum((y[0] * y[0] + y[1] * y[1]) + (y[2] * y[2] + y[3] * y[3])); float r = __builtin_amdgcn_rsqf(ss + NORM_EPS); if (sec == 0) r *= 0.08838834764831845f;
#pragma unroll
                  for (int j = 0; j < 4; ++j) y[j] *= r; }
              if (sec == 0) { u32x2 o; o.x = pk2(y[0], y[1]); o.y = pk2(y[2], y[3]); *(LAS u32x2*)(Qs + s * 136 + d0) = o;
                  o.x = pk2(y[0] * eg, y[1] * eg); o.y = pk2(y[2] * eg, y[3] * eg); *(u32x2*)(GQD + s * 128 + d0) = o; }
              else if (sec == 1) { u32x2 o; o.x = pk2(y[0], y[1]); o.y = pk2(y[2], y[3]); *(LAS u32x2*)(Ks + s * 136 + d0) = o;
                  const float f1 = bs * eg;
#pragma unroll
                  for (int j = 0; j < 4; ++j) { RHS[s * 256 + 128 + d0 + j] = y[j] * f1; KdT[(d0 + j) * 72 + s] = f2bf(y[j] * f2); } }
              else {
#pragma unroll
                  for (int j = 0; j < 4; ++j) RHS[s * 256 + d0 + j] = y[j] * bs; }
          }
      }
#undef GDN_LOADROW
    }
    __syncthreads();
    { const int kind = wave >> 2, tt = (wave >> 1) & 1, st = wave & 1, r31 = lane & 31, hh = lane >> 5;
      const LAS bf16_t* As = kind ? Qs : Ks;
      f32x16 acc = zero16();
#pragma unroll
      for (int ks = 0; ks < 8; ++ks) { const bf16x8 a = *(const LAS bf16x8*)(As + (32 * tt + r31) * 136 + 16 * ks + 8 * hh), bb = *(const LAS bf16x8*)(Ks + (32 * st + r31) * 136 + 16 * ks + 8 * hh);
          acc = mfma32(a, bb, acc); }
      const int j = 32 * st + r31; const float gj = gcL[j];
#pragma unroll
      for (int r = 0; r < 16; ++r) { const int i = 32 * tt + (r & 3) + 8 * (r >> 2) + 4 * hh;
          if (kind == 0) { Mx[j * 68 + i] = (j < i) ? betaL[i] * acc[r] * __expf(gcL[i] - gj) : 0.f; }
          else { GQK[i * 64 + j] = f2bf((j <= i) ? acc[r] * __expf(gcL[i] - gj) : 0.f); } } }
    __syncthreads();
    gdn_solve<true>(RHS, Mx, KdT, GUT, GW, GKDT, tid);
#if defined(GDN_SOLVE_TWICE)
    __syncthreads(); gdn_solve<false>(RHS, Mx, KdT, GUT, GW, GKDT, tid);
#endif
    __syncthreads();
}
#define BAR_LDS() do { asm volatile("s_waitcnt lgkmcnt(0)" ::: "memory"); __builtin_amdgcn_s_barrier(); asm volatile("" ::: "memory"); } while (0)
DI u32x2 pack4(const f32x4 v) { u32x2 o; o.x = pk2(v[0], v[1]); o.y = pk2(v[2], v[3]); return o; }
struct ScanGA { bf16x8 wfr[4]; f32x4 ut[2]; bf16x8 gk[2][2]; float dl; };
struct ScanGB { bf16x8 gqd[4], gqk[2]; };
struct ScanHA { bf16x8 hk[2][2], hv[2][2]; f32x4 hdec[2]; };
struct ScanHB { bf16x8 hqd[4], hat[2], hv[2][2]; };
DI void scan_load(ScanGA& L, const GAS unsigned char* ws, int u, int sl, int w, int lane) {
    const int r15 = lane & 15, quad = lane >> 4;
    const bf16_t* GW = (const bf16_t*)(ws + WS_G_W) + (size_t)u * 8192; const float* GUT = (const float*)(ws + WS_G_UT) + (size_t)u * 8192; const bf16_t* GKDT = (const bf16_t*)(ws + WS_G_KDT) + (size_t)u * 8192;
#pragma unroll
    for (int ks = 0; ks < 4; ++ks) L.wfr[ks] = *(const bf16x8*)(GW + (16 * w + r15) * 128 + 32 * ks + 8 * quad);
#pragma unroll
    for (int nt = 0; nt < 2; ++nt) L.ut[nt] = *(const f32x4*)(GUT + (sl * 32 + 16 * nt + r15) * 64 + 16 * w + 4 * quad);
#pragma unroll
    for (int t = 0; t < 2; ++t)
#pragma unroll
        for (int ks = 0; ks < 2; ++ks) L.gk[t][ks] = *(const bf16x8*)(GKDT + (32 * w + 16 * t + r15) * 64 + 32 * ks + 8 * quad);
    L.dl = ((const float*)(ws + WS_G_DL))[u];
}
DI void scan_load(ScanGB& L, const GAS unsigned char* ws, int u, int sl, int w, int lane) {
    const int r15 = lane & 15, quad = lane >> 4; (void)sl;
    const bf16_t* GQD = (const bf16_t*)(ws + WS_G_QD) + (size_t)u * 8192; const bf16_t* GQK = (const bf16_t*)(ws + WS_G_QK) + (size_t)u * 4096;
#pragma unroll
    for (int ks = 0; ks < 4; ++ks) L.gqd[ks] = *(const bf16x8*)(GQD + (16 * w + r15) * 128 + 32 * ks + 8 * quad);
#pragma unroll
    for (int ks = 0; ks < 2; ++ks) L.gqk[ks] = *(const bf16x8*)(GQK + (16 * w + r15) * 64 + 32 * ks + 8 * quad);
}
DI void scan_load(ScanHA& L, const GAS unsigned char* ws, int u, int sl, int w, int lane) {
    const int r15 = lane & 15, quad = lane >> 4;
    const bf16_t* HKDT = (const bf16_t*)(ws + WS_H_KDT) + (size_t)u * 8192; const bf16_t* HVT = (const bf16_t*)(ws + WS_H_VT) + (size_t)u * 8192;
#pragma unroll
    for (int t = 0; t < 2; ++t)
#pragma unroll
        for (int ks = 0; ks < 2; ++ks) { L.hk[t][ks] = *(const bf16x8*)(HKDT + (32 * w + 16 * t + r15) * 64 + 32 * ks + 8 * quad); L.hv[t][ks] = *(const bf16x8*)(HVT + (sl * 32 + 16 * t + r15) * 64 + 32 * ks + 8 * quad); }
#pragma unroll
    for (int t = 0; t < 2; ++t) L.hdec[t] = *(const f32x4*)((const float*)(ws + WS_H_DEC) + (size_t)u * 128 + 32 * w + 16 * t + 4 * quad);
}
DI void scan_load(ScanHB& L, const GAS unsigned char* ws, int u, int sl, int w, int lane) {
    const int r15 = lane & 15, quad = lane >> 4;
    const bf16_t* HQD = (const bf16_t*)(ws + WS_H_QD) + (size_t)u * 8192; const bf16_t* HATT = (const bf16_t*)(ws + WS_H_ATT) + (size_t)u * 4096; const bf16_t* HVT = (const bf16_t*)(ws + WS_H_VT) + (size_t)u * 8192;
#pragma unroll
    for (int ks = 0; ks < 4; ++ks) L.hqd[ks] = *(const bf16x8*)(HQD + (16 * w + r15) * 128 + 32 * ks + 8 * quad);
#pragma unroll
    for (int ks = 0; ks < 2; ++ks) { L.hat[ks] = *(const bf16x8*)(HATT + (16 * w + r15) * 64 + 32 * ks + 8 * quad);
#pragma unroll
        for (int nt = 0; nt < 2; ++nt) L.hv[nt][ks] = *(const bf16x8*)(HVT + (sl * 32 + 16 * nt + r15) * 64 + 32 * ks + 8 * quad); }
}
DI void scan_unit(const Ctx& C, int su) {
    const int tid = C.tid, lane = C.lane, wave = C.wave, r15 = lane & 15, quad = lane >> 4;
    const int kind = su >> 7, bh = (su >> 2) & 31, sl = su & 3, b = bh >> 3, h = bh & 7;
    LAS bf16_t* ST = (LAS bf16_t*)(C.lds);
    LAS bf16_t* VN = (LAS bf16_t*)(C.lds + 8704);
    for (int i = tid; i < 8704 / 4; i += 512) ((LAS unsigned*)C.lds)[i] = 0u;
    BAR_LDS();
    bf16_t* OAB = (bf16_t*)(C.ws + WS_OAB);
    const f32x4 z4 = {0.f, 0.f, 0.f, 0.f};
#define ST_FRAG(nt, ks) (*(const LAS bf16x8*)(ST + (16 * (nt) + r15) * 136 + 32 * (ks) + 8 * quad))
#define VN_FRAG(nt, ks) (*(const LAS bf16x8*)(VN + (16 * (nt) + r15) * 72 + 32 * (ks) + 8 * quad))
    if (kind == 0) {
        if (wave < 4) { const int w = wave;
            f32x4 S[2][2] = {{z4, z4}, {z4, z4}};
            ScanGA cur, nxt; scan_load(cur, C.ws, bh * 32, sl, w, lane);
            for (int c = 0; c < NCHUNK; ++c) {
                if (c + 1 < NCHUNK) scan_load(nxt, C.ws, bh * 32 + c + 1, sl, w, lane);
#pragma unroll
                for (int nt = 0; nt < 2; ++nt) { f32x4 acc = z4;
#pragma unroll
                    for (int ks = 0; ks < 4; ++ks) acc = mfma16(cur.wfr[ks], ST_FRAG(nt, ks), acc);
                    *(LAS u32x2*)(VN + (16 * nt + r15) * 72 + 16 * w + 4 * quad) = pack4(cur.ut[nt] - acc); }
                BAR_LDS();
#pragma unroll
                for (int t = 0; t < 2; ++t)
#pragma unroll
                    for (int nt = 0; nt < 2; ++nt) { f32x4 ag = z4;
#pragma unroll
                        for (int ks = 0; ks < 2; ++ks) ag = mfma16(cur.gk[t][ks], VN_FRAG(nt, ks), ag);
                        S[t][nt] = S[t][nt] * cur.dl + ag;
                        *(LAS u32x2*)(ST + (16 * nt + r15) * 136 + 32 * w + 16 * t + 4 * quad) = pack4(S[t][nt]); }
                BAR_LDS();
                if (c + 1 < NCHUNK) cur = nxt; }
        } else { const int w = wave - 4;
            ScanGB cur, nxt; scan_load(cur, C.ws, bh * 32, sl, w, lane);
            for (int c = 0; c < NCHUNK; ++c) {
                if (c + 1 < NCHUNK) scan_load(nxt, C.ws, bh * 32 + c + 1, sl, w, lane);
                f32x4 og[2] = {z4, z4};
#pragma unroll
                for (int nt = 0; nt < 2; ++nt)
#pragma unroll
                    for (int ks = 0; ks < 4; ++ks) og[nt] = mfma16(cur.gqd[ks], ST_FRAG(nt, ks), og[nt]);
                BAR_LDS();
#pragma unroll
                for (int nt = 0; nt < 2; ++nt) {
#pragma unroll
                    for (int ks = 0; ks < 2; ++ks) og[nt] = mfma16(cur.gqk[ks], VN_FRAG(nt, ks), og[nt]);
                    bf16_t* orow = OAB + (size_t)(b * T + 64 * c + 16 * w + 4 * quad) * 2048 + 1024 + h * 128 + sl * 32 + 16 * nt + r15;
#pragma unroll
                    for (int r = 0; r < 4; ++r) orow[(size_t)r * 2048] = f2bf(og[nt][r]); }
                BAR_LDS();
                if (c + 1 < NCHUNK) cur = nxt; }
        }
    } else {
        if (wave < 4) { const int w = wave;
            f32x4 S[2][2] = {{z4, z4}, {z4, z4}};
            ScanHA cur, nxt; scan_load(cur, C.ws, bh * 32, sl, w, lane);
            for (int c = 0; c < NCHUNK; ++c) {
                if (c + 1 < NCHUNK) scan_load(nxt, C.ws, bh * 32 + c + 1, sl, w, lane);
                BAR_LDS();
#pragma unroll
                for (int t = 0; t < 2; ++t)
#pragma unroll
                    for (int nt = 0; nt < 2; ++nt) { f32x4 ah = z4;
#pragma unroll
                        for (int ks = 0; ks < 2; ++ks) ah = mfma16(cur.hk[t][ks], cur.hv[nt][ks], ah);
                        S[t][nt] = S[t][nt] * cur.hdec[t] + ah;
                        *(LAS u32x2*)(ST + (16 * nt + r15) * 136 + 32 * w + 16 * t + 4 * quad) = pack4(S[t][nt]); }
                BAR_LDS();
                if (c + 1 < NCHUNK) cur = nxt; }
        } else { const int w = wave - 4;
            ScanHB cur, nxt; scan_load(cur, C.ws, bh * 32, sl, w, lane);
            for (int c = 0; c < NCHUNK; ++c) {
                if (c + 1 < NCHUNK) scan_load(nxt, C.ws, bh * 32 + c + 1, sl, w, lane);
                f32x4 oh[2] = {z4, z4};
#pragma unroll
                for (int nt = 0; nt < 2; ++nt)
#pragma unroll
                    for (int ks = 0; ks < 4; ++ks) oh[nt] = mfma16(cur.hqd[ks], ST_FRAG(nt, ks), oh[nt]);
                BAR_LDS();
#pragma unroll
                for (int nt = 0; nt < 2; ++nt) {
#pragma unroll
                    for (int ks = 0; ks < 2; ++ks) oh[nt] = mfma16(cur.hat[ks], cur.hv[nt][ks], oh[nt]);
                    bf16_t* orow = OAB + (size_t)(b * T + 64 * c + 16 * w + 4 * quad) * 2048 + h * 128 + sl * 32 + 16 * nt + r15;
#pragma unroll
                    for (int r = 0; r < 4; ++r) orow[(size_t)r * 2048] = f2bf(oh[nt][r]); }
                BAR_LDS();
                if (c + 1 < NCHUNK) cur = nxt; }
        }
    }
#undef ST_FRAG
#undef VN_FRAG
    BAR_LDS();
}
DI void phase_finalize_ab(const Ctx& C, int l) {
    const int gw = C.vcu * 8 + C.wave, NGW = C.G * 8, lane = C.lane, hs = lane >> 5, d0 = 4 * (lane & 31);
    const bf16_t* OAB = (const bf16_t*)(C.ws + WS_OAB); const bf16_t* Ybf = (const bf16_t*)(C.ws + WS_YBF); bf16_t* MIX = (bf16_t*)(C.ws + WS_MIX);
    for (int row = gw; row < M; row += NGW) {
#pragma unroll
        for (int i = 0; i < 8; ++i) { const int hv = 2 * i + hs, side = hv >> 3, h = hv & 7;
            const u32x2 ow = *(const u32x2*)(OAB + (size_t)row * 2048 + hv * 128 + d0); const f32x4 o = {bflo(ow.x), bfhi(ow.x), bflo(ow.y), bfhi(ow.y)};
            const float ss = half_sum((o[0] * o[0] + o[1] * o[1]) + (o[2] * o[2] + o[3] * o[3]));
            const float r = __builtin_amdgcn_rsqf(ss * (1.0f / 128.0f) + NORM_EPS);
            const f32x4 nw = *(const f32x4*)((side ? C.kin[IN_GD_NORM] : C.kin[IN_HG_NORM]) + l * 128 + d0);
            const u32x2 gw2 = *(const u32x2*)(Ybf + (size_t)row * LDY + (side ? Y_GZ : Y_HG) + h * 128 + d0);
            const float g0 = silu_f(bflo(gw2.x)), g1 = silu_f(bfhi(gw2.x)), g2 = silu_f(bflo(gw2.y)), g3 = silu_f(bfhi(gw2.y));
            u32x2 w; w.x = pk2(o[0] * r * nw[0] * g0, o[1] * r * nw[1] * g1); w.y = pk2(o[2] * r * nw[2] * g2, o[3] * r * nw[3] * g3);
            *(u32x2*)(MIX + (size_t)row * DM + hv * 128 + d0) = w; }
    }
}
DI float gelu_tanh(float x) { const float u = 0.7978845608028654f * (x + 0.044715f * x * x * x); return 0.5f * x * (1.0f + tanhf(u)); }
DI void cmp_mlp2_unit(const Ctx& C, int l, int e) {
    const int tid = C.tid, lane = C.lane, wave = C.wave, kv = e >> 7, bg = (e >> 3) & 15, nb = e & 7;
    const bf16_t* PQ = (const bf16_t*)(C.ws + WS_PQ); const float* c1p = (const float*)(C.ws + WS_C1) + kv * 8 * 256;
    LAS bf16_t* Hd = (LAS bf16_t*)C.lds;
    LAS float* c1s = (LAS float*)(C.lds + 16 * 264 * 2);
    if (tid < 256) { float c1 = 0.f;
#pragma unroll
        for (int q = 0; q < 8; ++q) c1 += c1p[q * 256 + tid];
        c1s[tid] = c1; }
    __syncthreads();
    { const int nn = tid >> 5, j0 = (tid & 31) * 8, n = 16 * nb + nn; float hv[8] = {0.f, 0.f, 0.f, 0.f, 0.f, 0.f, 0.f, 0.f};
      if (n <= 126) { const size_t r = (size_t)(kv * 2048 + bg * 128 + n); f32x4 a0 = {0.f, 0.f, 0.f, 0.f}, a1 = a0;
#pragma unroll
          for (int sp = 0; sp < 4; ++sp) { const bf16_t* pp = PQ + (size_t)sp * 4096 * 1024 + r * 1024 + kv * 512 + j0; const bf16_t* qp = pp + 1024 + 256;
              const u32x4 pw = *(const u32x4*)pp, qw = *(const u32x4*)qp;
              a0 += (f32x4){bflo(pw.x) + bflo(qw.x), bfhi(pw.x) + bfhi(qw.x), bflo(pw.y) + bflo(qw.y), bfhi(pw.y) + bfhi(qw.y)};
              a1 += (f32x4){bflo(pw.z) + bflo(qw.z), bfhi(pw.z) + bfhi(qw.z), bflo(pw.w) + bflo(qw.w), bfhi(pw.w) + bfhi(qw.w)}; }
#pragma unroll
          for (int j = 0; j < 4; ++j) { hv[j] = gelu_tanh(a0[j] + c1s[j0 + j]); hv[4 + j] = gelu_tanh(a1[j] + c1s[j0 + 4 + j]); } }
      u32x4 o; o.x = pk2(hv[0], hv[1]); o.y = pk2(hv[2], hv[3]); o.z = pk2(hv[4], hv[5]); o.w = pk2(hv[6], hv[7]);
      *(LAS u32x4*)(Hd + nn * 264 + j0) = o; }
    __syncthreads();
    { const int r15 = lane & 15, quad = lane >> 4; const bf16_t* W2T = (const bf16_t*)(C.ws + WS_W2T) + ((size_t)kv * 128 + 16 * wave + r15) * 256 + 8 * quad;
      bf16x8 bfr[8];
#pragma unroll
      for (int ks = 0; ks < 8; ++ks) bfr[ks] = *(const bf16x8*)(W2T + 32 * ks);
      f32x4 acc = {0.f, 0.f, 0.f, 0.f};
#pragma unroll
      for (int ks = 0; ks < 8; ++ks) acc = mfma16(*(const LAS bf16x8*)(Hd + r15 * 264 + 32 * ks + 8 * quad), bfr[ks], acc);
      bf16_t* dst = (bf16_t*)(C.ws + (kv ? WS_VCMP : WS_KCMP)) + ((size_t)bg * 128 + 16 * nb + 4 * quad) * 128 + 16 * wave + r15;
#pragma unroll
      for (int r = 0; r < 4; ++r) dst[(size_t)r * 128] = f2bf(acc[r]); }
    __syncthreads();
}
constexpr float ATT_SCALE = 0.08838834764831845f;
constexpr float ATT_C2 = ATT_SCALE * 1.4426950408889634f;
constexpr int KP = 136, VP = 160;
DI bf16x8 pack8(const f32x16& x, int s) {
    u32x4 p; p.x = pk2(x[8 * s], x[8 * s + 1]); p.y = pk2(x[8 * s + 2], x[8 * s + 3]); p.z = pk2(x[8 * s + 4], x[8 * s + 5]); p.w = pk2(x[8 * s + 6], x[8 * s + 7]);
    return __builtin_bit_cast(bf16x8, p);
}
DI void pv_step(f32x16 (&O)[4], const LAS bf16_t* Vt, int kb16, bf16x8 pf, int lane) {
    const int hh = lane >> 5, blk = (lane >> 4) & 1, q4 = (lane & 15) >> 2, p4 = lane & 3;
    const LAS bf16_t* base = Vt + (kb16 + 4 * hh + q4) * VP + 16 * blk + 4 * p4;
#pragma unroll
    for (int dt = 0; dt < 4; ++dt) { const s16x4 lo = tr_read(base + 32 * dt), hi = tr_read(base + 8 * VP + 32 * dt);
        const bf16x8 a = __builtin_shufflevector(lo, hi, 0, 1, 2, 3, 4, 5, 6, 7);
        O[dt] = mfma32(a, pf, O[dt]); }
}
DI void rope_q(bf16x8 (&Qf)[8], const float* cosT, const float* sinT, int tok, int hh) {
#pragma unroll
    for (int ks = 0; ks < 4; ++ks) {
        const float* cp = cosT + tok * 64 + 16 * ks + 8 * hh; const float* sp = sinT + tok * 64 + 16 * ks + 8 * hh;
        const f32x4 c0 = *(const f32x4*)cp, c1 = *(const f32x4*)(cp + 4), s0 = *(const f32x4*)sp, s1 = *(const f32x4*)(sp + 4);
        const u32x4 a = __builtin_bit_cast(u32x4, Qf[ks]), b = __builtin_bit_cast(u32x4, Qf[ks + 4]); u32x4 oa, ob;
#define RQ(w, cA, cB, sA, sB) { const float x1a = bflo(a.w), x1b = bfhi(a.w), x2a = bflo(b.w), x2b = bfhi(b.w); oa.w = pk2(x1a * (cA) - x2a * (sA), x1b * (cB) - x2b * (sB)); ob.w = pk2(x2a * (cA) + x1a * (sA), x2b * (cB) + x1b * (sB)); }
        RQ(x, c0[0], c0[1], s0[0], s0[1]) RQ(y, c0[2], c0[3], s0[2], s0[3]) RQ(z, c1[0], c1[1], s1[0], s1[1]) RQ(w, c1[2], c1[3], s1[2], s1[3])
#undef RQ
        Qf[ks] = __builtin_bit_cast(bf16x8, oa); Qf[ks + 4] = __builtin_bit_cast(bf16x8, ob); }
}
DI void cmp_attn_unit(const Ctx& C, int f) {
    const int tid = C.tid, lane = C.lane, wave = C.wave, r31 = lane & 31, hh = lane >> 5;
    const int bg = f >> 5, it = f & 31, b = bg >> 2, g = bg & 3, t0 = 64 * it;
    LAS bf16_t* Kc = (LAS bf16_t*)C.lds;
    LAS bf16_t* Vc = (LAS bf16_t*)(C.lds + 128 * KP * 2);
    LAS float* IMP = (LAS float*)(C.lds + 128 * KP * 2 + 128 * VP * 2);
    const bf16_t* Ybf = (const bf16_t*)(C.ws + WS_YBF);
    { const bf16_t* kg = (const bf16_t*)(C.ws + WS_KCMP) + (size_t)bg * 16384; const bf16_t* vg = (const bf16_t*)(C.ws + WS_VCMP) + (size_t)bg * 16384;
#pragma unroll
      for (int k = 0; k < 4; ++k) { const int piece = tid + 512 * k, row = piece >> 4, ch = piece & 15;
          *(LAS u32x4*)(Kc + row * KP + ch * 8) = *(const u32x4*)(kg + row * 128 + ch * 8); *(LAS u32x4*)(Vc + row * VP + ch * 8) = *(const u32x4*)(vg + row * 128 + ch * 8); } }
    const int head = 4 * g + (wave >> 1), tq = 32 * (wave & 1), tok = t0 + tq + r31;
    bf16x8 Qf[8];
    { const bf16_t* qp = Ybf + (size_t)(b * T + tok) * LDY + Y_NQ + head * 128 + 8 * hh;
#pragma unroll
      for (int ks = 0; ks < 8; ++ks) Qf[ks] = *(const bf16x8*)(qp + 16 * ks); }
    rope_q(Qf, (const float*)(C.ws + WS_ROPE_C), (const float*)(C.ws + WS_ROPE_S), tok, hh);
    __syncthreads();
    f32x16 S[4];
#pragma unroll
    for (int kt = 0; kt < 4; ++kt) { S[kt] = zero16();
#pragma unroll
        for (int ks = 0; ks < 8; ++ks) S[kt] = mfma32(*(const LAS bf16x8*)(Kc + (32 * kt + r31) * KP + 16 * ks + 8 * hh), Qf[ks], S[kt]); }
    float m = -1e30f;
#pragma unroll
    for (int kt = 0; kt < 4; ++kt)
#pragma unroll
        for (int r = 0; r < 16; ++r) { const int n = 32 * kt + (r & 3) + 8 * (r >> 2) + 4 * hh; const bool ok = (n <= 126) && (16 * n + 31 <= tok); const float sc = S[kt][r] * ATT_SCALE; if (ok) m = fmaxf(m, sc); }
    m = xhalf_max(m);
    float sum = 0.f;
#pragma unroll
    for (int kt = 0; kt < 4; ++kt)
#pragma unroll
        for (int r = 0; r < 16; ++r) { const int n = 32 * kt + (r & 3) + 8 * (r >> 2) + 4 * hh; const bool ok = (n <= 126) && (16 * n + 31 <= tok); const float e = ok ? __expf(S[kt][r] * ATT_SCALE - m) : 0.f; S[kt][r] = e; sum += e; }
    sum = xhalf_sum(sum);
    const float inv = sum > 0.f ? 1.0f / sum : 0.f;
#pragma unroll
    for (int kt = 0; kt < 4; ++kt) S[kt] = S[kt] * inv;
    { LAS float* ip = IMP + (wave * 32 + r31) * 33; float carry = 0.f;
#pragma unroll
      for (int kt = 0; kt < 4; ++kt) { float a[4], pc[4];
#pragma unroll
          for (int rho = 0; rho < 4; ++rho) { a[rho] = (S[kt][4 * rho] + S[kt][4 * rho + 1]) + (S[kt][4 * rho + 2] + 0.5f * S[kt][4 * rho + 3]); pc[rho] = __shfl_xor(0.5f * S[kt][4 * rho + 3], 32); }
#pragma unroll
          for (int rho = 0; rho < 4; ++rho) { const float prev0 = (rho > 0) ? pc[rho > 0 ? rho - 1 : 0] : carry;
              ip[8 * kt + 2 * rho + hh] = a[rho] + (hh ? pc[rho] : prev0); }
          carry = pc[3]; } }
    f32x16 O[4];
#pragma unroll
    for (int dt = 0; dt < 4; ++dt) O[dt] = zero16();
#pragma unroll
    for (int kt = 0; kt < 4; ++kt)
#pragma unroll
        for (int s = 0; s < 2; ++s) pv_step(O, Vc, 32 * kt + 16 * s, pack8(S[kt], s), lane);
    { bf16_t* op = (bf16_t*)(C.ws + WS_OCMP) + (size_t)(b * T + tok) * 2048 + head * 128 + 4 * hh;
#pragma unroll
      for (int dt = 0; dt < 4; ++dt)
#pragma unroll
          for (int rho = 0; rho < 4; ++rho) { u32x2 w; w.x = pk2(O[dt][4 * rho], O[dt][4 * rho + 1]); w.y = pk2(O[dt][4 * rho + 2], O[dt][4 * rho + 3]); *(u32x2*)(op + 32 * dt + 8 * rho) = w; } }
    __syncthreads();
    if (tid < 64) { const int q = tid & 31, w0 = tid >> 5; unsigned mask;
        if (it < 16) mask = (2u << it) - 1u;
        else { float imp[32];
#pragma unroll
            for (int j = 0; j < 32; ++j) imp[j] = (IMP[((0 + w0) * 32 + q) * 33 + j] + IMP[((2 + w0) * 32 + q) * 33 + j]) + (IMP[((4 + w0) * 32 + q) * 33 + j] + IMP[((6 + w0) * 32 + q) * 33 + j]);
            mask = 1u | (1u << it) | (1u << (it - 1));
#pragma unroll
            for (int j = 1; j < 30; ++j) { if (j <= it - 2) { int rank = 0;
#pragma unroll
                    for (int k = 1; k < 30; ++k) { if (k <= it - 2) rank += (imp[k] > imp[j] || (imp[k] == imp[j] && k < j)) ? 1 : 0; }
                    if (rank < 13) mask |= (1u << j); } } }
        ((unsigned*)(C.ws + WS_SEL))[bg * T + t0 + tid] = mask; }
    __syncthreads();
}
template <int MODE>
DI void attn_tile(f32x16 (&O)[4], float& m, float& lsum, const bf16x8 (&Qf)[8], const LAS bf16_t* Kt, const LAS bf16_t* Vt, int kpos0, int tok, bool selbit, bool edge, int lane) {
    const int r31 = lane & 31, hh = lane >> 5;
    f32x16 S[2];
    { bf16x8 kf0[8], kf1[8];
      const LAS bf16_t* kb = Kt + r31 * KP + 8 * hh;
#pragma unroll
      for (int ks = 0; ks < 8; ++ks) kf0[ks] = *(const LAS bf16x8*)(kb + 16 * ks);
      __builtin_amdgcn_sched_barrier(0);
#pragma unroll
      for (int ks = 0; ks < 8; ++ks) kf1[ks] = *(const LAS bf16x8*)(kb + 32 * KP + 16 * ks);
      S[0] = zero16(); S[1] = zero16();
      __builtin_amdgcn_sched_barrier(0);
#pragma unroll
      for (int ks = 0; ks < 8; ++ks) S[0] = mfma32(kf0[ks], Qf[ks], S[0]);
      __builtin_amdgcn_sched_barrier(0);
#pragma unroll
      for (int ks = 0; ks < 8; ++ks) S[1] = mfma32(kf1[ks], Qf[ks], S[1]); }
    if (edge) {
#pragma unroll
        for (int kt = 0; kt < 2; ++kt)
#pragma unroll
            for (int r = 0; r < 16; ++r) { const int kp = kpos0 + 32 * kt + (r & 3) + 8 * (r >> 2) + 4 * hh;
                const bool ok = (MODE == 0) ? (kp <= tok) : (kp <= tok && kp > tok - 512);
                S[kt][r] = ok ? S[kt][r] : -INFINITY; } }
    float mx = -INFINITY;
#pragma unroll
    for (int kt = 0; kt < 2; ++kt)
#pragma unroll
        for (int r = 0; r < 16; ++r) mx = fmaxf(mx, S[kt][r]);
    mx = xhalf_max(mx) * ATT_C2;
    const bool rowon = (MODE != 0) || selbit;
    if (!rowon) mx = -INFINITY;
    if (__any(mx > m + 8.0f)) {
        const float mn = fmaxf(m, mx), alpha = __builtin_amdgcn_exp2f(m - mn);
        lsum *= alpha; m = mn;
#pragma unroll
        for (int dt = 0; dt < 4; ++dt) O[dt] = O[dt] * alpha; }
    const float mref = rowon ? m : INFINITY;
    float rs = 0.f;
#pragma unroll
    for (int kt = 0; kt < 2; ++kt)
#pragma unroll
        for (int r = 0; r < 16; ++r) { const float p = __builtin_amdgcn_exp2f(__builtin_fmaf(S[kt][r], ATT_C2, -mref)); S[kt][r] = p; rs += p; }
    rs = xhalf_sum(rs);
    lsum += rs;
    { const int blk = (lane >> 4) & 1, q4 = (lane & 15) >> 2, p4 = lane & 3;
      const LAS bf16_t* vb = Vt + (4 * hh + q4) * VP + 16 * blk + 4 * p4;
      s16x4 va[8], vbf[8];
#define PV_LOAD(dst, st) do { _Pragma("unroll") for (int dt = 0; dt < 4; ++dt) { dst[2 * dt] = tr_read(vb + (16 * (st)) * VP + 32 * dt); dst[2 * dt + 1] = tr_read(vb + (16 * (st) + 8) * VP + 32 * dt); } } while (0)
#define PV_MMA(src, pf) do { _Pragma("unroll") for (int dt = 0; dt < 4; ++dt) O[dt] = mfma32(__builtin_shufflevector(src[2 * dt], src[2 * dt + 1], 0, 1, 2, 3, 4, 5, 6, 7), pf, O[dt]); } while (0)
      PV_LOAD(va, 0);
      const bf16x8 p0 = pack8(S[0], 0), p1 = pack8(S[0], 1), p2 = pack8(S[1], 0), p3 = pack8(S[1], 1);
      PV_LOAD(vbf, 1); PV_MMA(va, p0);
      PV_LOAD(va, 2);  PV_MMA(vbf, p1);
      PV_LOAD(vbf, 3); PV_MMA(va, p2);
      PV_MMA(vbf, p3);
#undef PV_LOAD
#undef PV_MMA
    }
}
DI void kv_load(u32x4 (&kr)[2], u32x4 (&vr)[2], const bf16_t* kg, const bf16_t* vg, int tid) {
#pragma unroll
    for (int k = 0; k < 2; ++k) { const int piece = tid + 512 * k, key = piece >> 4, ch = piece & 15;
        kr[k] = *(const u32x4*)(kg + (size_t)key * LDY + ch * 8); vr[k] = *(const u32x4*)(vg + (size_t)key * LDY + ch * 8); }
}
DI void kv_store(const u32x4 (&kr)[2], const u32x4 (&vr)[2], LAS bf16_t* Kt, LAS bf16_t* Vt, int tid) {
#pragma unroll
    for (int k = 0; k < 2; ++k) { const int piece = tid + 512 * k, key = piece >> 4, ch = piece & 15;
        *(LAS u32x4*)(Kt + key * KP + ch * 8) = kr[k]; *(LAS u32x4*)(Vt + key * VP + ch * 8) = vr[k]; }
}
DI void slc_win_unit(const Ctx& C, int bg, int it) {
    const int tid = C.tid, lane = C.lane, wave = C.wave, r31 = lane & 31, hh = lane >> 5;
    const int b = bg >> 2, g = bg & 3, t0 = 64 * it;
    LAS bf16_t* Kb0 = (LAS bf16_t*)C.lds; LAS bf16_t* Kb1 = Kb0 + 64 * KP; LAS bf16_t* Vb0 = Kb1 + 64 * KP; LAS bf16_t* Vb1 = Vb0 + 64 * VP;
    LAS unsigned* uni = (LAS unsigned*)(Vb1 + 64 * VP);
    const bf16_t* Ybf = (const bf16_t*)(C.ws + WS_YBF); const float* Yf = (const float*)(C.ws + WS_YF);
    const int head = 4 * g + (wave >> 1), tq = 32 * (wave & 1), tok = t0 + tq + r31; const size_t row = (size_t)(b * T + tok);
    const unsigned sel = ((const unsigned*)(C.ws + WS_SEL))[bg * T + tok];
    if (wave < 2) { unsigned u = sel;
#pragma unroll
        for (int o = 1; o < 32; o <<= 1) u |= __shfl_xor(u, o);
        if (lane == 0) uni[wave] = u; }
    bf16x8 Qf[8];
    { const bf16_t* qp = Ybf + row * LDY + Y_NQ + head * 128 + 8 * hh;
#pragma unroll
      for (int ks = 0; ks < 8; ++ks) Qf[ks] = *(const bf16x8*)(qp + 16 * ks); }
    rope_q(Qf, (const float*)(C.ws + WS_ROPE_C), (const float*)(C.ws + WS_ROPE_S), tok, hh);
    __syncthreads();
    unsigned umask = __builtin_amdgcn_readfirstlane(uni[0] | uni[1]);
    const bf16_t* kbase = Ybf + (size_t)(b * T) * LDY + Y_KS + g * 128; const bf16_t* vbase = Ybf + (size_t)(b * T) * LDY + Y_VS + g * 128;
    f32x16 O[4]; float m = -1e30f, lsum = 0.f;
#pragma unroll
    for (int dt = 0; dt < 4; ++dt) O[dt] = zero16();
    u32x4 kr[2], vr[2];
    { int j = __builtin_ctz(umask); umask &= umask - 1u;
      kv_load(kr, vr, kbase + (size_t)(64 * j) * LDY, vbase + (size_t)(64 * j) * LDY, tid); kv_store(kr, vr, Kb0, Vb0, tid);
      __syncthreads();
      int par = 0;
      for (;;) { const bool more = umask != 0u; int jn = 0;
          if (more) { jn = __builtin_ctz(umask); umask &= umask - 1u; kv_load(kr, vr, kbase + (size_t)(64 * jn) * LDY, vbase + (size_t)(64 * jn) * LDY, tid); }
          attn_tile<0>(O, m, lsum, Qf, par ? Kb1 : Kb0, par ? Vb1 : Vb0, 64 * j, tok, ((sel >> j) & 1u) != 0u, j == it, lane);
          if (!more) break;
          kv_store(kr, vr, par ? Kb0 : Kb1, par ? Vb0 : Vb1, tid);
          __syncthreads();
          par ^= 1; j = jn; } }
    const float inv1 = 1.0f / lsum;
    LAS bf16_t* osl = (LAS bf16_t*)(C.lds + 76800) + (wave * 32 + r31) * 136 + 4 * hh;
#pragma unroll
    for (int dt = 0; dt < 4; ++dt)
#pragma unroll
        for (int rho = 0; rho < 4; ++rho) { u32x2 w; w.x = pk2(O[dt][4 * rho] * inv1, O[dt][4 * rho + 1] * inv1); w.y = pk2(O[dt][4 * rho + 2] * inv1, O[dt][4 * rho + 3] * inv1); *(LAS u32x2*)(osl + 32 * dt + 8 * rho) = w; }
    m = -1e30f; lsum = 0.f;
#pragma unroll
    for (int dt = 0; dt < 4; ++dt) O[dt] = zero16();
    __syncthreads();
    { int j = it > 8 ? it - 8 : 0;
      kv_load(kr, vr, kbase + (size_t)(64 * j) * LDY + (Y_KW - Y_KS), vbase + (size_t)(64 * j) * LDY + (Y_VW - Y_VS), tid); kv_store(kr, vr, Kb0, Vb0, tid);
      __syncthreads();
      int par = 0;
      for (;;) { const bool more = j < it;
          if (more) kv_load(kr, vr, kbase + (size_t)(64 * (j + 1)) * LDY + (Y_KW - Y_KS), vbase + (size_t)(64 * (j + 1)) * LDY + (Y_VW - Y_VS), tid);
          attn_tile<1>(O, m, lsum, Qf, par ? Kb1 : Kb0, par ? Vb1 : Vb0, 64 * j, tok, true, (j == it) || (j == it - 8), lane);
          if (!more) break;
          kv_store(kr, vr, par ? Kb0 : Kb1, par ? Vb0 : Vb1, tid);
          __syncthreads();
          par ^= 1; ++j; } }
    const float inv2 = 1.0f / lsum;
    const float* gp = Yf + row * LDF + F_GATE + head * 3;
    const float g0 = sigmoid_f(gp[0]), g1 = sigmoid_f(gp[1]), g2 = sigmoid_f(gp[2]) * inv2;
    const bf16_t* ocp = (const bf16_t*)(C.ws + WS_OCMP) + row * 2048 + head * 128 + 4 * hh;
    bf16_t* mx = (bf16_t*)(C.ws + WS_MIX) + row * DM + 2048 + head * 128 + 4 * hh;
#pragma unroll
    for (int dt = 0; dt < 4; ++dt)
#pragma unroll
        for (int rho = 0; rho < 4; ++rho) { const u32x2 ocw = *(const u32x2*)(ocp + 32 * dt + 8 * rho), osw = *(const LAS u32x2*)(osl + 32 * dt + 8 * rho);
            const f32x4 oc = {bflo(ocw.x), bfhi(ocw.x), bflo(ocw.y), bfhi(ocw.y)}, os = {bflo(osw.x), bfhi(osw.x), bflo(osw.y), bfhi(osw.y)};
            u32x2 w; w.x = pk2(g0 * oc[0] + g1 * os[0] + g2 * O[dt][4 * rho], g0 * oc[1] + g1 * os[1] + g2 * O[dt][4 * rho + 1]);
            w.y = pk2(g0 * oc[2] + g1 * os[2] + g2 * O[dt][4 * rho + 2], g0 * oc[3] + g1 * os[3] + g2 * O[dt][4 * rho + 3]);
            *(u32x2*)(mx + 32 * dt + 8 * rho) = w; }
    __syncthreads();
}
}

#ifndef MK_N_LAUNCHES
#define MK_N_LAUNCHES 1
#endif
constexpr int PH_PER_LAYER = 10, N_PHASES = 2 + hy::DEPTH * PH_PER_LAYER;
struct Args { const float* in[hy::N_INPUTS]; float* out; unsigned char* ws; int ph_lo, ph_hi; };
static_assert(sizeof(Args) == hy::N_INPUTS * 8 + 24, "Args has padding");

__global__ void __launch_bounds__(512, 2) hy_fwd(Args args) {
    using namespace hy;
    extern __shared__ __attribute__((aligned(16))) unsigned char lds_raw[];
    Ctx C0;
    { Ctx& C = C0;
    C.lds = (LAS unsigned char*)lds_raw;
    C.tid = threadIdx.x; C.lane = C.tid & 63; C.wave = __builtin_amdgcn_readfirstlane(C.tid >> 6);
    C.G = gridDim.x; { const int bx = blockIdx.x; C.vcu = (C.G % 8 == 0) ? (bx % 8) * (C.G / 8) + bx / 8 : bx; }
    C.kin = (const float* const __attribute__((address_space(4)))*)__builtin_amdgcn_kernarg_segment_ptr();
    C.out = (GAS float*)args.out; C.ws = (GAS unsigned char*)args.ws; }
    const Ctx& C = C0;
    volatile LAS unsigned* MISC = (volatile LAS unsigned*)(C.lds + MISC_OFF);
    if (C.tid < 64) MISC[C.tid] = 0u;
    __syncthreads();
    const int lo = args.ph_lo, hi = args.ph_hi;
    unsigned* ctl = (unsigned*)(C.ws + WS_CTL);
    XcdBarrier bar; bar.bar = ctl + CW_BAR; bar.x = 0; bar.st = MISC + 8;
    if (hi - lo > 1) { bar = xcd_barrier_post(ctl + CW_BAR, MISC + 8); bar.wv = C.wave; }
    int ph = 0;
#ifndef P4_SEL
#define P4_SEL 3
#endif
#ifndef P0_MODE
#define P0_MODE 0
#endif
#ifndef P0_REPS
#define P0_REPS 1
#endif
#ifndef BAR_REPS
#define BAR_REPS 1
#endif
#ifndef P3R_REPS
#define P3R_REPS 1
#endif
#ifndef P3H_REPS
#define P3H_REPS 1
#endif
#ifndef P3G_REPS
#define P3G_REPS 1
#endif
#ifndef P3_SEL
#define P3_SEL 7
#endif
#ifndef PH_MASK
#define PH_MASK 0xFFFFFFFFu
#endif
#define PH_EN(k) (((PH_MASK) >> (k)) & 1u)
#ifndef PH_REPM
#define PH_REPM 0x0u
#endif
#define PH_REP(k) (((PH_REPM) >> (k)) & 1u)
#define PHASE(k, ...) PH_BEGIN if (PH_EN(k)) { __VA_ARGS__ } if (PH_REP(k)) { { XcdBarrier bq = bar; GAS unsigned* gb_ = (GAS unsigned*)bar.bar; asm volatile("" : "+s"(gb_), "+s"(bq.x)); bq.bar = (unsigned*)gb_; xcd_barrier(bq); } __VA_ARGS__ } PH_END
#define PH_BEGIN if (ph >= lo && ph < hi) { Ctx P = C0; asm volatile("" : "+s"(P.ws), "+s"(P.kin), "+s"(P.wave), "+s"(P.vcu), "+s"(P.G)); P.lane = lane_id_fresh(); P.tid = P.wave * 64 + P.lane; const Ctx& C = P;
#define PH_END if (ph + 1 < hi) { XcdBarrier bq = bar; GAS unsigned* gb_ = (GAS unsigned*)bar.bar; asm volatile("" : "+s"(gb_), "+s"(bq.x)); bq.bar = (unsigned*)gb_; _Pragma("nounroll") for (int rep_ = 0; rep_ < BAR_REPS; ++rep_) xcd_barrier(bq); } } ++ph;

    PHASE(13, phase_tables(C);)
#define Hb ((bf16_t*)(C.ws + WS_H))
#define Ybf ((bf16_t*)(C.ws + WS_YBF))
#define Yf ((float*)(C.ws + WS_YF))
#define XA ((float*)(C.ws + WS_XA))
#define Hb1 ((bf16_t*)(C.ws + WS_XA))
#define XB ((float*)(C.ws + WS_XB))
#define ACT ((bf16_t*)(C.ws + WS_ACT))
#define MIX ((bf16_t*)(C.ws + WS_MIX))
#define xin ((l == 0) ? C.kin[IN_X] : (const float*)XB)
    for (int l = 0; l < DEPTH; ++l) {
        PHASE(0, _Pragma("nounroll") for (int rep = 1; rep < P0_REPS; ++rep) { phase_p0_t<P0_MODE>(C, l); __syncthreads(); } phase_p0(C, l); __syncthreads(); if (l == 0) phase_xcvt(C, C.kin[IN_X], Hb, (unsigned long long*)(C.ws + WS_RSB));)
        PHASE(2, { constexpr int GC = 256 - P0_NDED, rem = ((M / 256) * (NINP / 256)) % GC;
            if (C.G == 256 && (int)blockIdx.x >= GC) p0_fill_in_ded(C, l, (int)blockIdx.x - GC, P0_NDED);
            else { pg8::Gemm g{Hb, (const bf16_t*)(C.ws + WS_WIN_L(l)), M, NINP, DM}; pg8::StaticOrder S; S.init(M, NINP, (C.G == 256) ? GC : C.G, (int)blockIdx.x);
                pg8::EpiIn E{Ybf, Yf, LDY, LDF, NBF_TILES, (const unsigned long long*)(C.ws + WS_RSB), 1.0f / DM, NORM_EPS}; pg8::gemm_phase<pg8::EpiIn, pg8::StaticOrder, true, true>(C.lds, g, S, E, C.wave);
                if (C.G == 256 && rem && (int)blockIdx.x >= rem) { __syncthreads(); p0_fill_in_tail(C, l, (int)blockIdx.x - rem, GC - rem); } } })
        PHASE(3, if (P3_SEL & 1) phase_rope(C); _Pragma("nounroll") for (int rep = 1; rep < P3R_REPS; ++rep) { __syncthreads(); phase_rope(C, -1.0f); __syncthreads(); phase_rope(C, 1.0f); }
            _Pragma("nounroll") for (int rep = 0; rep < P3H_REPS; ++rep) for (int u = C.vcu; u < NUNIT; u += C.G) hgrn_pre_unit(C, l, u);
            _Pragma("nounroll") for (int rep = 0; rep < P3G_REPS; ++rep) for (int u = C.vcu; u < NUNIT; u += C.G) gdn_pre_unit(C, l, u);)
        PHASE(4, if (P4_SEL & 1) { pg8::Gemm g{(const bf16_t*)(C.ws + WS_KCV), (const bf16_t*)(C.ws + WS_W1CAT), 4096, 1024, 512, 2048, 2048}; pg8::CmpOrder S{C.G, (int)blockIdx.x};
            pg8::EpiRes E{(bf16_t*)(C.ws + WS_PQ), 1024, (size_t)4096 * 1024}; pg8::gemm_phase<pg8::EpiRes, pg8::CmpOrder, false, true>(C.lds, g, S, E, C.wave); }
            __syncthreads();
            if (P4_SEL & 2) for (int su = C.vcu; su < 256; su += C.G) scan_unit(C, su);)
        PHASE(5, for (int e = C.vcu; e < 256; e += C.G) cmp_mlp2_unit(C, l, e);
            phase_finalize_ab(C, l);)
        PHASE(6, for (int f = C.vcu; f < 512; f += C.G) cmp_attn_unit(C, f);)
        PHASE(7, for (int k = C.vcu; k < 512; k += C.G) { const int kk = k & 255, bg = kk >> 4, ii = kk & 15; slc_win_unit(C, bg, (k < 256) ? ii : 31 - ii); })
        PHASE(8, { pg8::Gemm g{MIX, (const bf16_t*)(C.ws + WS_WOUT), M, DM, DM}; pg8::StaticOrder S; S.init(M, DM, C.G, (int)blockIdx.x);
            pg8::EpiResNorm E{(l == 0) ? C.kin[IN_X] : (const float*)nullptr, Hb, Hb1, (unsigned long long*)(C.ws + WS_RSA), DM}; pg8::gemm_phase<pg8::EpiResNorm, pg8::StaticOrder, true, true>(C.lds, g, S, E, C.wave); })
        PHASE(10, { pg8::Gemm g{Hb1, (const bf16_t*)(C.ws + WS_WGU), M, 2 * FF, DM}; pg8::StaticOrder S; S.init(M, 2 * FF, C.G, (int)blockIdx.x);
            pg8::EpiSwiGLU E{ACT, FF, (const unsigned long long*)(C.ws + WS_RSA), 1.0f / DM, NORM_EPS}; pg8::gemm_phase<pg8::EpiSwiGLU, pg8::StaticOrder, true, true>(C.lds, g, S, E, C.wave); }
            if (C.G == 256) { constexpr int rem = ((M / 256) * (2 * FF / 256)) % 256; if (rem && (int)blockIdx.x >= rem) { __syncthreads(); p0_fill_wdown(C, l, (int)blockIdx.x - rem, 256 - rem); } })
        PHASE(11, { pg8::Gemm g{ACT, (const bf16_t*)(C.ws + WS_WD), M, DM, FF}; pg8::StaticOrder S; S.init(M, DM, C.G, (int)blockIdx.x);
            pg8::EpiResNorm E{nullptr, Hb1, Hb, (unsigned long long*)(C.ws + WS_RSB), DM}; pg8::gemm_phase<pg8::EpiResNorm, pg8::StaticOrder, true, true>(C.lds, g, S, E, C.wave); })
    }
    PHASE(12, phase_final_norm(C, Hb, C.kin[IN_FINAL_NORM], (float*)C.out);)
#undef PH_BEGIN
#undef Hb
#undef Ybf
#undef Yf
#undef XA
#undef Hb1
#undef XB
#undef ACT
#undef MIX
#undef xin
#undef PH_END
}

extern "C" void kernel_launch(void* const* d_in, const int* in_sizes, int n_in, void* d_out, int out_size, void* d_ws, size_t ws_size, hipStream_t stream) {
    static int grid = 0;
    if (grid == 0) {
        if (n_in != hy::N_INPUTS || in_sizes[0] != hy::M * hy::DM || out_size != hy::M * hy::DM || ws_size < hy::WS_END) {
            fprintf(stderr, "kernel_launch: built for %d inputs, x/out of %d floats, >= %zu bytes of workspace; got n_in %d, in0 %d, out %d, ws %zu; nothing launched\n", hy::N_INPUTS, hy::M * hy::DM, (size_t)hy::WS_END, n_in, n_in > 0 ? in_sizes[0] : -1, out_size, ws_size); grid = -1; return; }
        int dev = 0, cus = 0, per_cu = 0;
        if (hipGetDevice(&dev) != hipSuccess || hipDeviceGetAttribute(&cus, hipDeviceAttributeMultiprocessorCount, dev) != hipSuccess) { fprintf(stderr, "kernel_launch: device query failed\n"); grid = -1; return; }
        if (hipFuncSetAttribute((const void*)hy_fwd, hipFuncAttributeMaxDynamicSharedMemorySize, hy::LDS_BYTES) != hipSuccess) { fprintf(stderr, "kernel_launch: hipFuncSetAttribute failed\n"); grid = -1; return; }
        if (hipOccupancyMaxActiveBlocksPerMultiprocessor(&per_cu, (const void*)hy_fwd, 512, hy::LDS_BYTES) != hipSuccess || per_cu < 1)
            fprintf(stderr, "kernel_launch: note: occupancy query reports %d workgroups per CU\n", per_cu);
        (void)hipGetLastError();
        grid = cus;
    }
    if (grid < 0) return;
    if (hipMemsetAsync((char*)d_ws + hy::WS_CTL, 0, hy::CTL_BYTES, stream) != hipSuccess) { fprintf(stderr, "kernel_launch: memset failed\n"); return; }
    Args a{};
    for (int i = 0; i < hy::N_INPUTS; ++i) a.in[i] = (const float*)d_in[i];
    a.out = (float*)d_out; a.ws = (unsigned char*)d_ws;
#if MK_N_LAUNCHES == 1
    a.ph_lo = 0; a.ph_hi = N_PHASES;
    hipLaunchKernelGGL(hy_fwd, dim3(grid), dim3(512), hy::LDS_BYTES, stream, a);
#else
    for (int p = 0; p < N_PHASES; ++p) { a.ph_lo = p; a.ph_hi = p + 1; hipLaunchKernelGGL(hy_fwd, dim3(grid), dim3(512), hy::LDS_BYTES, stream, a); }
#endif
    const hipError_t le = hipPeekAtLastError();
    if (le != hipSuccess) fprintf(stderr, "kernel_launch: launch failed: %s\n", hipGetErrorName(le));
}
```

```cpp
#include <hip/hip_runtime.h>
#include <cstdio>
#include <cstdint>
namespace pg8 {
#define PG8_LAS __attribute__((address_space(3)))
typedef unsigned short bf16_t;
typedef short bf16x8 __attribute__((ext_vector_type(8)));
typedef float f32x4 __attribute__((ext_vector_type(4)));
typedef unsigned u32x4 __attribute__((ext_vector_type(4)));
constexpr int BM = 256, BK = 64, HALF = 128, HTB = HALF * BK * 2  , STAGE_BYTES = 8 * HTB, NXCD = 8, WGM = 4;

__host__ __device__ __forceinline__ int lds_byte(int r, int c) { const int st = (r >> 4) * 2 + (c >> 5), rr = r & 15, cc = c & 31, ob = rr * 64 + cc * 2; return st * 1024 + (ob ^ (((ob >> 9) & 1) << 5)); }
__host__ __device__ __forceinline__ void stage_rc(int b, int& R, int& C) { const int st = b / 1024, sb = b % 1024, swz = sb ^ (((sb >> 9) & 1) << 5); R = (st >> 1) * 16 + swz / 64; C = (st & 1) * 32 + (swz % 64) / 2; }
__host__ __device__ __forceinline__ int perm32(int rho) { const int n = rho >> 4, i = rho & 15; return 8 * (i >> 2) + 4 * n + (i & 3); }

struct Unit { int pm, pn, ko = 0; };
struct Gemm { const bf16_t* A; const bf16_t* Bt; int M, N, K; int lda = 0, ldb = 0; };

struct StaticOrder {
    int nM, nN, nwg, G, c;
    __host__ __device__ void init(int M, int N, int G_, int c_) { nM = M / BM; nN = N / BM; nwg = nM * nN; G = G_; c = c_; }
    __host__ __device__ bool next(int i, Unit& u) const {
        const long L = (long)i * G + c; if (L >= nwg) return false;
        int wgid = (int)L; { const int q = nwg / NXCD, r = nwg % NXCD, xcd = wgid % NXCD, off = wgid / NXCD; wgid = (xcd < r ? xcd * (q + 1) : r * (q + 1) + (xcd - r) * q) + off; }
        const int nig = WGM * nN, gid = wgid / nig, fm = gid * WGM, gsz = (nM - fm) < WGM ? (nM - fm) : WGM;
        u.pm = fm + ((wgid % nig) % gsz); u.pn = (wgid % nig) / gsz; return true;
    }
    __device__ __forceinline__ void a_ready(const Unit&) const {}
    __device__ __forceinline__ void done(const Unit&) const {}
};
typedef float f32x2 __attribute__((ext_vector_type(2)));
typedef unsigned u32x2 __attribute__((ext_vector_type(2)));
typedef __bf16 bf16x2_t __attribute__((ext_vector_type(2)));
__device__ __forceinline__ unsigned cvt_pk_bf16(float lo, float hi) { f32x2 v = {lo, hi}; bf16x2_t r = __builtin_convertvector(v, bf16x2_t); return __builtin_bit_cast(unsigned, r); }

struct EpiIn {
    static constexpr bool PERM = true, AFTER_DRAIN = false;
    bf16_t* Ybf; float* Yf; int ldy, ldf, nbf; const unsigned long long* rs; float inv_k, eps;
    __device__ __forceinline__ void operator()(const f32x4 (&acc)[2][2][4][2], const Unit& u, int wr, int wc, int fr, int fq) const {
        const int row0 = u.pm * BM + wr * 64 + fr;
        float rr[2][4];
#pragma unroll
        for (int ai = 0; ai < 2; ++ai)
#pragma unroll
            for (int m = 0; m < 4; ++m) rr[ai][m] = 1.0f / sqrtf((float)rs[row0 + ai * HALF + m * 16] * (inv_k * (1.0f / 1048576.0f)) + eps);
        if (u.pn < nbf) {
            const int col0 = u.pn * BM + wc * 32 + 8 * fq;
#pragma unroll
            for (int ai = 0; ai < 2; ++ai)
#pragma unroll
                for (int m = 0; m < 4; ++m) { bf16_t* rowp = Ybf + (size_t)(row0 + ai * HALF + m * 16) * ldy + col0;
#pragma unroll
                    for (int bj = 0; bj < 2; ++bj) { const f32x4 v0 = acc[ai][bj][m][0] * rr[ai][m], v1 = acc[ai][bj][m][1] * rr[ai][m];
                        u32x4 w; w.x = cvt_pk_bf16(v0[0], v0[1]); w.y = cvt_pk_bf16(v0[2], v0[3]); w.z = cvt_pk_bf16(v1[0], v1[1]); w.w = cvt_pk_bf16(v1[2], v1[3]);
                        *(u32x4*)(rowp + bj * HALF) = w; } }
        } else {
            const int col0 = (u.pn - nbf) * BM + wc * 32 + 8 * fq;
#pragma unroll
            for (int ai = 0; ai < 2; ++ai)
#pragma unroll
                for (int m = 0; m < 4; ++m) { float* rowp = Yf + (size_t)(row0 + ai * HALF + m * 16) * ldf + col0;
#pragma unroll
                    for (int bj = 0; bj < 2; ++bj) { *(f32x4*)(rowp + bj * HALF) = acc[ai][bj][m][0] * rr[ai][m]; *(f32x4*)(rowp + bj * HALF + 4) = acc[ai][bj][m][1] * rr[ai][m]; } }
        }
    }
};
struct EpiRes {
    static constexpr bool PERM = false, AFTER_DRAIN = false;
    bf16_t* C0; int ldc; size_t split_stride;
    __device__ __forceinline__ void operator()(const f32x4 (&acc)[2][2][4][2], const Unit& u, int wr, int wc, int fr, int fq) const {
        bf16_t* C = C0 + (size_t)(u.ko >> 9) * split_stride;
        const int row0 = u.pm * BM + wr * 64 + fr, col0 = u.pn * BM + wc * 32 + 4 * fq;
#pragma unroll
        for (int ai = 0; ai < 2; ++ai)
#pragma unroll
            for (int m = 0; m < 4; ++m) { const size_t off = (size_t)(row0 + ai * HALF + m * 16) * ldc + col0;
#pragma unroll
                for (int bj = 0; bj < 2; ++bj)
#pragma unroll
                    for (int n = 0; n < 2; ++n) { const f32x4 v = acc[ai][bj][m][n]; u32x2 w; w.x = cvt_pk_bf16(v[0], v[1]); w.y = cvt_pk_bf16(v[2], v[3]); *(u32x2*)(C + off + bj * HALF + n * 16) = w; } }
    }
};
struct EpiResNorm {
    static constexpr bool PERM = true, AFTER_DRAIN = false;
    const float* basef; const bf16_t* Hin; bf16_t* Hb; unsigned long long* rs; int ldc;
    __device__ __forceinline__ void operator()(const f32x4 (&acc)[2][2][4][2], const Unit& u, int wr, int wc, int fr, int fq) const {
        const int row0 = u.pm * BM + wr * 64 + fr, col0 = u.pn * BM + wc * 32 + 8 * fq;
#pragma unroll
        for (int ai = 0; ai < 2; ++ai)
#pragma unroll
            for (int m = 0; m < 4; ++m) { const int row = row0 + ai * HALF + m * 16; const size_t off = (size_t)row * ldc + col0; float ss = 0.f;
#pragma unroll
                for (int bj = 0; bj < 2; ++bj) { f32x4 b0, b1;
                    if (basef) { b0 = *(const f32x4*)(basef + off + bj * HALF); b1 = *(const f32x4*)(basef + off + bj * HALF + 4); }
                    else { const u32x4 bw = *(const u32x4*)(Hin + off + bj * HALF);
                        b0 = (f32x4){__builtin_bit_cast(float, bw.x << 16), __builtin_bit_cast(float, bw.x & 0xffff0000u), __builtin_bit_cast(float, bw.y << 16), __builtin_bit_cast(float, bw.y & 0xffff0000u)};
                        b1 = (f32x4){__builtin_bit_cast(float, bw.z << 16), __builtin_bit_cast(float, bw.z & 0xffff0000u), __builtin_bit_cast(float, bw.w << 16), __builtin_bit_cast(float, bw.w & 0xffff0000u)}; }
                    const f32x4 v0 = acc[ai][bj][m][0] + b0, v1 = acc[ai][bj][m][1] + b1;
                    u32x4 w; w.x = cvt_pk_bf16(v0[0], v0[1]); w.y = cvt_pk_bf16(v0[2], v0[3]); w.z = cvt_pk_bf16(v1[0], v1[1]); w.w = cvt_pk_bf16(v1[2], v1[3]);
                    *(u32x4*)(Hb + off + bj * HALF) = w;
                    ss += ((v0[0] * v0[0] + v0[1] * v0[1]) + (v0[2] * v0[2] + v0[3] * v0[3])) + ((v1[0] * v1[0] + v1[1] * v1[1]) + (v1[2] * v1[2] + v1[3] * v1[3])); }
                { const auto r16_ = __builtin_amdgcn_permlane16_swap(__float_as_uint(ss), __float_as_uint(ss), false, false); ss = __uint_as_float(r16_[0]) + __uint_as_float(r16_[1]);
                  const auto r32_ = __builtin_amdgcn_permlane32_swap(__float_as_uint(ss), __float_as_uint(ss), false, false); ss = __uint_as_float(r32_[0]) + __uint_as_float(r32_[1]); }
                if (fq == 0) atomicAdd(rs + row, (unsigned long long)(ss * 1048576.0f + 0.5f)); }
    }
};
struct EpiSwiGLU {
    static constexpr bool PERM = true, AFTER_DRAIN = false;
    bf16_t* O; int ldc; const unsigned long long* rs; float inv_k, eps;
    __device__ __forceinline__ void operator()(const f32x4 (&acc)[2][2][4][2], const Unit& u, int wr, int wc, int fr, int fq) const {
        const int row0 = u.pm * BM + wr * 64 + fr, col0 = u.pn * HALF + wc * 32 + 8 * fq;
#pragma unroll
        for (int ai = 0; ai < 2; ++ai)
#pragma unroll
            for (int m = 0; m < 4; ++m) { bf16_t* rowp = O + (size_t)(row0 + ai * HALF + m * 16) * ldc + col0;
                float r[8]; const float rr = 1.0f / sqrtf((float)rs[row0 + ai * HALF + m * 16] * (inv_k * (1.0f / 1048576.0f)) + eps);
#pragma unroll
                for (int n = 0; n < 2; ++n)
#pragma unroll
                    for (int j = 0; j < 4; ++j) { const float g = acc[ai][0][m][n][j] * rr, up = acc[ai][1][m][n][j] * rr; r[4 * n + j] = g * up * __builtin_amdgcn_rcpf(1.0f + __expf(-g)); }
                u32x4 w; w.x = cvt_pk_bf16(r[0], r[1]); w.y = cvt_pk_bf16(r[2], r[3]); w.z = cvt_pk_bf16(r[4], r[5]); w.w = cvt_pk_bf16(r[6], r[7]);
                *(u32x4*)rowp = w; }
    }
};
struct CmpOrder {
    int G, c;
    __device__ __forceinline__ bool next(int i, Unit& u) const { const int L = i * G + c; if (L >= 128) return false; const int b = L >> 2, kv = b >> 4; u.pm = 8 * kv + (b & 7); u.pn = 2 * kv + ((b >> 3) & 1); u.ko = (L & 3) * 512; return true; }
    __device__ __forceinline__ void a_ready(const Unit&) const {}
    __device__ __forceinline__ void done(const Unit&) const {}
};
template <class Epi, class Sched, bool ALIGN_EPI = false, bool SP2 = false>
__device__ __forceinline__ void gemm_phase(PG8_LAS unsigned char* lds, const Gemm g, const Sched& S, const Epi& E, const int wv  ) {
    unsigned zl_ = 0u; asm volatile("" : "+s"(zl_)); int tid_ = wv * 64 + (int)__builtin_amdgcn_mbcnt_hi(~0u, __builtin_amdgcn_mbcnt_lo(~0u, zl_)); asm volatile("" : "+v"(tid_));
    const int tid = tid_, wid = __builtin_amdgcn_readfirstlane(tid >> 6), lane = tid & 63, wr = wid >> 2, wc = wid & 3, fr = lane & 15, fq = lane >> 4;
    const int K = g.K, nt = K / BK, lda = g.lda ? g.lda : K, ldb = g.ldb ? g.ldb : K;
    unsigned voffA[2], voffB[2];
#pragma unroll
    for (int i = 0; i < 2; ++i) { int R, C; stage_rc(tid * 16 + i * 8192, R, C); const int Rb = Epi::PERM ? ((R & ~31) + perm32(R & 31)) : R;
        voffA[i] = (unsigned)(R * lda + C) * 2u; voffB[i] = (unsigned)(Rb * ldb + C) * 2u; }
    const size_t kstep = (size_t)(BK * 2);
    const size_t hstepA = (size_t)HALF * lda * 2, hstepB = (size_t)HALF * ldb * 2;
    const size_t tstepA = 2 * hstepA, tstepB = 2 * hstepB;
    const unsigned ldsw = (unsigned)wid * 1024u;
    const int aoff = lds_byte(wr * 64 + fr, fq * 8), boff = lds_byte(wc * 32 + fr, fq * 8);
#define PG8_SA(b, h) (((b) * 2 + (h)) * HTB)
#define PG8_SB(b, h) ((4 + (b) * 2 + (h)) * HTB)
#define PG8_STAGE(bufoff, gbase, voff) do { _Pragma("unroll") for (int _i = 0; _i < 2; ++_i) \
        __builtin_amdgcn_global_load_lds((const unsigned*)((const char*)(gbase) + (voff)[_i]), (PG8_LAS unsigned*)(lds + (bufoff) + ldsw + _i * 8192), 16, 0, 0); } while (0)
#define PG8_LDA(dst, b, h) do { _Pragma("unroll") for (int m = 0; m < 4; ++m) _Pragma("unroll") for (int k = 0; k < 2; ++k) dst[m][k] = *(const PG8_LAS bf16x8*)(lds + PG8_SA(b, h) + aoff + m * 2048 + k * 1024); } while (0)
#define PG8_LDB(dst, b, h) do { _Pragma("unroll") for (int n = 0; n < 2; ++n) _Pragma("unroll") for (int k = 0; k < 2; ++k) dst[n][k] = *(const PG8_LAS bf16x8*)(lds + PG8_SB(b, h) + boff + n * 2048 + k * 1024); } while (0)
#define PG8_MMA(ai, bj, At, Bt) do { __builtin_amdgcn_s_setprio(1); _Pragma("unroll") for (int m = 0; m < 4; ++m) _Pragma("unroll") for (int n = 0; n < 2; ++n) _Pragma("unroll") for (int k = 0; k < 2; ++k) \
        acc[ai][bj][m][n] = __builtin_amdgcn_mfma_f32_16x16x32_bf16(Bt[n][k], At[m][k], acc[ai][bj][m][n], 0, 0, 0); __builtin_amdgcn_s_setprio(0); } while (0)
#define PG8_WAIT_V(n) asm volatile("s_waitcnt vmcnt(" #n ")" ::: "memory")
#define PG8_WAIT_L(n) asm volatile("s_waitcnt lgkmcnt(" #n ")" ::: "memory")
#define PG8_BAR __builtin_amdgcn_s_barrier()
#define PG8_SCHED __builtin_amdgcn_sched_barrier(0)
    Unit cur, nxt; int ui = 0;
    if (!S.next(0, cur)) return;
    f32x4 acc[2][2][4][2];
#pragma unroll
    for (int a = 0; a < 2; ++a)
#pragma unroll
        for (int b = 0; b < 2; ++b)
#pragma unroll
            for (int m = 0; m < 4; ++m)
#pragma unroll
                for (int n = 0; n < 2; ++n) acc[a][b][m][n] = (f32x4){0.f, 0.f, 0.f, 0.f};
    bf16x8 At[4][2], B0[2][2], B1[2][2];
    const char* cA = (const char*)g.A + (size_t)cur.pm * tstepA + (size_t)cur.ko * 2; const char* cB = (const char*)g.Bt + (size_t)cur.pn * tstepB + (size_t)cur.ko * 2;
    S.a_ready(cur);
    if constexpr (SP2) {
        PG8_STAGE(PG8_SB(0, 0), cB, voffB); PG8_STAGE(PG8_SB(0, 1), cB + hstepB, voffB); PG8_STAGE(PG8_SA(0, 0), cA, voffA); PG8_STAGE(PG8_SA(0, 1), cA + hstepA, voffA);
        if (wr == 1) PG8_BAR;
        PG8_WAIT_V(2); PG8_BAR;
        PG8_STAGE(PG8_SB(1, 0), cB + kstep, voffB); PG8_STAGE(PG8_SA(1, 0), cA + kstep, voffA); PG8_STAGE(PG8_SB(1, 1), cB + hstepB + kstep, voffB);
        PG8_WAIT_V(6); PG8_BAR;
    } else {
        PG8_STAGE(PG8_SB(0, 0), cB, voffB); PG8_STAGE(PG8_SA(0, 0), cA, voffA); PG8_STAGE(PG8_SB(0, 1), cB + hstepB, voffB); PG8_STAGE(PG8_SA(0, 1), cA + hstepA, voffA);
        if (wr == 1) PG8_BAR;
        PG8_WAIT_V(4); PG8_BAR;
        PG8_STAGE(PG8_SB(1, 0), cB + kstep, voffB); PG8_STAGE(PG8_SA(1, 0), cA + kstep, voffA); PG8_STAGE(PG8_SB(1, 1), cB + hstepB + kstep, voffB);
        PG8_WAIT_V(6); PG8_BAR;
    }
    for (;;) {
        const bool has_next = S.next(ui + 1, nxt);
        const char* nA = has_next ? (const char*)g.A + (size_t)nxt.pm * tstepA + (size_t)nxt.ko * 2 : cA; const char* nB = has_next ? (const char*)g.Bt + (size_t)nxt.pn * tstepB + (size_t)nxt.ko * 2 : cB;
        for (int t = 0; t < nt; t += 2) {
            const bool last = (t == nt - 2);
            const char* a1 = cA + (size_t)(t + 1) * kstep;
            const char* a2 = last ? nA : cA + (size_t)(t + 2) * kstep; const char* b2 = last ? nB : cB + (size_t)(t + 2) * kstep;
            const char* a3 = a2 + kstep; const char* b3 = b2 + kstep;
            if (last && has_next) S.a_ready(nxt);
            if constexpr (SP2) {
            PG8_LDB(B0, 0, 0); PG8_LDB(B1, 0, 1); PG8_SCHED; PG8_LDA(At, 0, 0); PG8_STAGE(PG8_SA(1, 1), a1 + hstepA, voffA);
            PG8_WAIT_V(8); PG8_WAIT_L(0); PG8_BAR; PG8_MMA(0, 0, At, B0); PG8_MMA(0, 1, At, B1); PG8_BAR; PG8_SCHED;
            PG8_LDA(At, 0, 1); PG8_STAGE(PG8_SB(0, 0), b2, voffB); PG8_STAGE(PG8_SB(0, 1), b2 + hstepB, voffB); PG8_STAGE(PG8_SA(0, 0), a2, voffA);
            PG8_WAIT_V(8); PG8_WAIT_L(0); PG8_BAR; PG8_MMA(1, 0, At, B0); PG8_MMA(1, 1, At, B1); PG8_BAR; PG8_SCHED;
            PG8_LDB(B0, 1, 0); PG8_LDB(B1, 1, 1); PG8_SCHED; PG8_LDA(At, 1, 0); PG8_STAGE(PG8_SA(0, 1), a2 + hstepA, voffA);
            PG8_WAIT_V(8); PG8_WAIT_L(0); PG8_BAR; PG8_MMA(0, 0, At, B0); PG8_MMA(0, 1, At, B1); PG8_BAR; PG8_SCHED;
            PG8_LDA(At, 1, 1); PG8_STAGE(PG8_SB(1, 0), b3, voffB); PG8_STAGE(PG8_SB(1, 1), b3 + hstepB, voffB); PG8_STAGE(PG8_SA(1, 0), a3, voffA);
            PG8_WAIT_V(8); PG8_WAIT_L(0); PG8_BAR; PG8_MMA(1, 0, At, B0); PG8_MMA(1, 1, At, B1); PG8_BAR; PG8_SCHED;
            } else {
            PG8_LDB(B0, 0, 0); PG8_SCHED; PG8_LDA(At, 0, 0); PG8_STAGE(PG8_SA(1, 1), a1 + hstepA, voffA);
            PG8_WAIT_L(8); PG8_BAR; PG8_WAIT_L(0); PG8_MMA(0, 0, At, B0); PG8_BAR; PG8_SCHED;
            PG8_LDB(B1, 0, 1); PG8_STAGE(PG8_SB(0, 0), b2, voffB);
            PG8_BAR; PG8_WAIT_L(0); PG8_MMA(0, 1, At, B1); PG8_BAR;
            PG8_LDA(At, 0, 1); PG8_STAGE(PG8_SA(0, 0), a2, voffA);
            PG8_BAR; PG8_WAIT_L(0); PG8_MMA(1, 0, At, B0); PG8_BAR; PG8_SCHED;
            PG8_STAGE(PG8_SB(0, 1), b2 + hstepB, voffB);
            PG8_WAIT_V(6); PG8_BAR; PG8_MMA(1, 1, At, B1); PG8_BAR;
            PG8_LDB(B0, 1, 0); PG8_SCHED; PG8_LDA(At, 1, 0); PG8_STAGE(PG8_SA(0, 1), a2 + hstepA, voffA);
            PG8_WAIT_L(8); PG8_BAR; PG8_WAIT_L(0); PG8_MMA(0, 0, At, B0); PG8_BAR; PG8_SCHED;
            PG8_LDB(B1, 1, 1); PG8_STAGE(PG8_SB(1, 0), b3, voffB);
            PG8_BAR; PG8_WAIT_L(0); PG8_MMA(0, 1, At, B1); PG8_BAR;
            PG8_LDA(At, 1, 1); PG8_STAGE(PG8_SA(1, 0), a3, voffA);
            PG8_BAR; PG8_WAIT_L(0); PG8_MMA(1, 0, At, B0); PG8_BAR; PG8_SCHED;
            PG8_STAGE(PG8_SB(1, 1), b3 + hstepB, voffB);
            PG8_WAIT_V(6); PG8_BAR; PG8_MMA(1, 1, At, B1); PG8_BAR;
            }
        }
        if constexpr (ALIGN_EPI) { if (wr == 0) PG8_BAR; }
        if constexpr (!Epi::AFTER_DRAIN) { E(acc, cur, wr, wc, fr, fq); S.done(cur); }
        if (!has_next) break;
#pragma unroll
        for (int a = 0; a < 2; ++a)
#pragma unroll
            for (int b = 0; b < 2; ++b)
#pragma unroll
                for (int m = 0; m < 4; ++m)
#pragma unroll
                    for (int n = 0; n < 2; ++n) acc[a][b][m][n] = (f32x4){0.f, 0.f, 0.f, 0.f};
        cur = nxt; cA = nA; cB = nB; ++ui;
        if constexpr (ALIGN_EPI) { if (wr == 1) PG8_BAR; }
    }
    PG8_WAIT_V(0);
    if constexpr (!ALIGN_EPI) { if (wr == 0) PG8_BAR; }
    PG8_BAR;
    if constexpr (Epi::AFTER_DRAIN) { E.fused(acc, cur, wr, wc, fr, fq, lds, wid, lane); S.done(cur); }
#undef PG8_SA
#undef PG8_SB
#undef PG8_STAGE
#undef PG8_LDA
#undef PG8_LDB
#undef PG8_MMA
#undef PG8_WAIT_V
#undef PG8_WAIT_L
#undef PG8_BAR
#undef PG8_SCHED
}
}
#define GAS __attribute__((address_space(1)))
#define LAS __attribute__((address_space(3)))
#define XB_TMO      128
#define XB_XCNT(j)  (256  + 64 * (j))
#define XB_XSUB(j)  (1280 + 64 * (j))
#define XB_XGEN(j)  (2304 + 64 * (j))
#define XB_TOP      3328
#define XB_TOPGEN   3392
#define XCD_BAR_WORDS 3456
#define XB_SPIN_CAP (1u << 18)

__device__ __forceinline__ unsigned xb_ld(unsigned* p)              { return __hip_atomic_load(p, __ATOMIC_RELAXED, __HIP_MEMORY_SCOPE_AGENT); }
__device__ __forceinline__ unsigned xb_add(unsigned* p, unsigned v) { return __hip_atomic_fetch_add(p, v, __ATOMIC_RELAXED, __HIP_MEMORY_SCOPE_AGENT); }
__device__ __forceinline__ unsigned xb_xcc_id() { return (unsigned)__builtin_amdgcn_s_getreg((3 << 11) | 20) & 0xFu; }
#define XB_SPIN(cond, bar) do { unsigned _sp = 0; while (cond) { __builtin_amdgcn_s_sleep(1); \
    if ((++_sp & 255u) == 0u) { if (xb_ld(&(bar)[XB_TMO])) break; if (_sp > XB_SPIN_CAP) { atomicAdd(&(bar)[XB_TMO], 1u); break; } } } } while (0)

struct XcdBarrier {
    int wv;
    unsigned* bar; unsigned x;
    volatile LAS unsigned* st;
};

__device__ __forceinline__ XcdBarrier xcd_barrier_post(unsigned* bar, volatile LAS unsigned* st) {
    XcdBarrier b; b.bar = bar; b.x = xb_xcc_id(); b.st = st;
    if (threadIdx.x == 0) (void)xb_add(&bar[XB_XCNT(b.x)], 1u);
    return b;
}
__device__ __forceinline__ void xcd_barrier_complete(unsigned* bar, unsigned x, unsigned& nloc, unsigned& nx) {
    const unsigned G = gridDim.x * gridDim.y * gridDim.z;
    unsigned sum, cnt, mine, sp = 0u;
    for (;;) {
        sum = 0u; cnt = 0u; mine = 0u;
#pragma unroll
        for (unsigned j = 0; j < 16; ++j) { const unsigned c = xb_ld(&bar[XB_XCNT(j)]); sum += c; cnt += (c > 0u) ? 1u : 0u; mine = (j == x) ? c : mine; }
        if (sum == G) break;
        __builtin_amdgcn_s_sleep(1);
        if ((++sp & 255u) == 0u) { if (xb_ld(&bar[XB_TMO])) break; if (sp > XB_SPIN_CAP) { atomicAdd(&bar[XB_TMO], 1u); break; } }
    }
    nloc = mine > 0u ? mine : 1u; nx = cnt > 0u ? cnt : 1u;
}

__device__ __forceinline__ void xcd_barrier(const XcdBarrier& b) {
    asm volatile("s_waitcnt vmcnt(0)" ::: "memory");
    __syncthreads();
    unsigned zl_ = 0u; asm volatile("" : "+s"(zl_));
    if (b.wv == 0 && __builtin_amdgcn_mbcnt_hi(~0u, __builtin_amdgcn_mbcnt_lo(~0u, zl_)) == 0u) {
        unsigned* bar = b.bar;
        __builtin_amdgcn_s_waitcnt(0);
        unsigned nloc = b.st[0], nx = b.st[1];
        if (nloc == 0u) { xcd_barrier_complete(bar, b.x, nloc, nx); b.st[0] = nloc; b.st[1] = nx; }
        const unsigned old = xb_add(&bar[XB_XSUB(b.x)], 1u);
        const unsigned gen = old / nloc;
        if (old + 1u == (gen + 1u) * nloc) {
            __builtin_amdgcn_fence(__ATOMIC_RELEASE, "agent");
            asm volatile("s_waitcnt vmcnt(0)" ::: "memory");
            const unsigned og = xb_add(&bar[XB_TOP], 1u);
            const unsigned tg = og / nx;
            if (og + 1u == (tg + 1u) * nx) xb_add(&bar[XB_TOPGEN], 1u);
            else XB_SPIN(xb_ld(&bar[XB_TOPGEN]) == tg, bar);
            __builtin_amdgcn_fence(__ATOMIC_ACQUIRE, "agent");
            xb_add(&bar[XB_XGEN(b.x)], 1u);
            asm volatile("s_waitcnt vmcnt(0)" ::: "memory");
        } else {
            XB_SPIN(xb_ld(&bar[XB_XGEN(b.x)]) == gen, bar);
            __builtin_amdgcn_fence(__ATOMIC_ACQUIRE, "agent");
            asm volatile("s_waitcnt vmcnt(0)" ::: "memory");
        }
    }
    __syncthreads();
}
namespace hy {
#define DI __device__ __forceinline__
typedef unsigned short bf16_t;
typedef short bf16x8 __attribute__((ext_vector_type(8)));
typedef short s16x4 __attribute__((ext_vector_type(4)));
typedef short v4i16_t __attribute__((ext_vector_type(4)));
typedef float f32x2 __attribute__((ext_vector_type(2)));
typedef float f32x4 __attribute__((ext_vector_type(4)));
typedef float f32x16 __attribute__((ext_vector_type(16)));
typedef unsigned u32x2 __attribute__((ext_vector_type(2)));
typedef unsigned u32x4 __attribute__((ext_vector_type(4)));
typedef __bf16 bf16x2_t __attribute__((ext_vector_type(2)));

constexpr int DM = 4096, NB = 4, T = 2048, M = NB * T, DEPTH = 2;
constexpr int NIN = 13376, NINP = 13568, LDY = 12288, LDF = 1280, NBF_TILES = 48;
constexpr int FF = 11008;
constexpr int NCHUNK = T / 64;
constexpr float NORM_EPS = 1e-6f;
constexpr int Y_HQ = 0, Y_HI = 1024, Y_HG = 2048, Y_GQ = 3072, Y_GK = 4096, Y_GV = 5120, Y_GZ = 6144, Y_NQ = 7168, Y_KC = 9216, Y_VC = 9728, Y_KS = 10240, Y_VS = 10752, Y_KW = 11264, Y_VW = 11776;
constexpr int F_HF = 0, F_GA = 1024, F_GB = 1032, F_GATE = 1040;
enum { IN_X = 0, IN_ATTN_NORM, IN_W_IN, IN_W_OUT, IN_FFN_NORM, IN_W_GATE, IN_W_UP, IN_W_DOWN, IN_FINAL_NORM, IN_LB, IN_HG_NORM, IN_CONV, IN_ALOG, IN_DTB, IN_GD_NORM,
       IN_POS_K, IN_W1_K, IN_W2_K, IN_POS_V, IN_W1_V, IN_W2_V, N_INPUTS };

constexpr size_t al256(size_t x) { return (x + 255) & ~(size_t)255; }
constexpr size_t WS_CTL = 0, CTL_BYTES = 1u << 20;
constexpr size_t WS_ROPE_C = WS_CTL + CTL_BYTES;
constexpr size_t WS_ROPE_S = WS_ROPE_C + (size_t)T * 64 * 4;
constexpr size_t WS_C1 = WS_ROPE_S + (size_t)T * 64 * 4;
constexpr size_t WS_RSA = WS_C1 + 2 * 8 * 256 * 4;
constexpr size_t WS_RSB = WS_RSA + (size_t)M * 8;
constexpr size_t WS_W2T = al256(WS_RSB + (size_t)M * 8);
constexpr size_t WS_W1CAT = WS_W2T + (size_t)2 * 128 * 256 * 2;
constexpr size_t WS_WIN = WS_W1CAT + (size_t)2 * 512 * 2048 * 2;
constexpr size_t WS_WOUT = WS_WIN + (size_t)NINP * DM * 2;
constexpr size_t WS_WGU = WS_WOUT + (size_t)DM * DM * 2;
constexpr size_t WS_WD = WS_WGU + (size_t)2 * FF * DM * 2;
constexpr size_t WS_H = WS_WD + (size_t)DM * FF * 2;
constexpr size_t WS_YBF = WS_H + (size_t)M * DM * 2;
constexpr size_t WS_YF = WS_YBF + (size_t)M * LDY * 2;
constexpr size_t WS_XA = WS_YF + (size_t)M * LDF * 4;
constexpr size_t WS_XB = WS_XA + (size_t)M * DM * 4;
constexpr size_t WS_ACT = WS_YBF;
constexpr size_t WS_MIX = WS_XB + (size_t)M * DM * 4;
constexpr size_t WS_KCV = WS_MIX + (size_t)M * DM * 2;
constexpr size_t WS_PQ = WS_KCV + (size_t)2 * 16 * T * 128 * 2;
constexpr size_t WS_KCMP = WS_PQ + (size_t)4 * 4096 * 1024 * 4;
constexpr size_t WS_VCMP = WS_KCMP + (size_t)16 * 128 * 128 * 2;
constexpr size_t WS_SEL = WS_VCMP + (size_t)16 * 128 * 128 * 2;
constexpr size_t WS_OCMP = WS_SEL + (size_t)16 * T * 4;
constexpr size_t WS_OSLC = WS_OCMP + (size_t)M * 2048 * 4;
constexpr size_t WS_OAB = WS_OSLC + (size_t)M * 2048 * 4;
constexpr int NUNIT = NB * 8 * NCHUNK;
constexpr size_t WS_G_UT = WS_OAB + (size_t)M * 2048 * 4;
constexpr size_t WS_G_W = WS_G_UT + (size_t)NUNIT * 128 * 64 * 4;
constexpr size_t WS_G_QD = WS_G_W + (size_t)NUNIT * 64 * 128 * 2;
constexpr size_t WS_G_KDT = WS_G_QD + (size_t)NUNIT * 64 * 128 * 2;
constexpr size_t WS_G_QK = WS_G_KDT + (size_t)NUNIT * 64 * 128 * 2;
constexpr size_t WS_G_DL = WS_G_QK + (size_t)NUNIT * 64 * 64 * 2;
constexpr size_t WS_H_QD = al256(WS_G_DL + (size_t)NUNIT * 4);
constexpr size_t WS_H_KDT = WS_H_QD + (size_t)NUNIT * 64 * 128 * 2;
constexpr size_t WS_H_ATT = WS_H_KDT + (size_t)NUNIT * 64 * 128 * 2;
constexpr size_t WS_H_VT = WS_H_ATT + (size_t)NUNIT * 64 * 64 * 2;
constexpr size_t WS_H_DEC = WS_H_VT + (size_t)NUNIT * 64 * 128 * 2;
constexpr size_t WS_WIN2 = al256(WS_H_DEC + (size_t)NUNIT * 128 * 4);
constexpr size_t WS_END = al256(WS_WIN2 + (size_t)NINP * DM * 2);
static_assert((size_t)M * FF * 2 <= (size_t)M * LDY * 2, "ACT overlay fits in Ybf");
static_assert(WS_END <= 1780000000ull, "workspace budget (ws_size >= sum of inputs = 1.806 GB)");
constexpr int CW_BAR = 4096;

#define WS_WIN_L(l) (((l) & 1) ? WS_WIN2 : WS_WIN)
constexpr int LDS_BYTES = 147456;
constexpr int MISC_OFF = LDS_BYTES - 256;
constexpr int SCR_BYTES = MISC_OFF;

DI float bf2f(bf16_t v) { return __builtin_bit_cast(float, (unsigned)v << 16); }
DI float bflo(unsigned w) { return __builtin_bit_cast(float, w << 16); }
DI float bfhi(unsigned w) { return __builtin_bit_cast(float, w & 0xffff0000u); }
DI unsigned pk2(float lo, float hi) { f32x2 v = {lo, hi}; bf16x2_t r = __builtin_convertvector(v, bf16x2_t); return __builtin_bit_cast(unsigned, r); }
DI bf16_t f2bf(float f) { return (bf16_t)(pk2(f, 0.f) & 0xffffu); }
DI float sigmoid_f(float x) { return __builtin_amdgcn_rcpf(1.0f + __expf(-x)); }
DI float silu_f(float x) { return x * __builtin_amdgcn_rcpf(1.0f + __expf(-x)); }
DI float softplus_f(float x) { return fmaxf(x, 0.f) + log1pf(__expf(-fabsf(x))); }
#define DPP_F(v, ctrl) __builtin_bit_cast(float, __builtin_amdgcn_mov_dpp(__builtin_bit_cast(int, (v)), (ctrl), 0xF, 0xF, true))
DI float row16_sum(float v) {
    v += DPP_F(v, 0xB1); v += DPP_F(v, 0x4E); v += DPP_F(v, 0x141); v += DPP_F(v, 0x140); return v;
}
DI int lane_id_fresh() { unsigned z = 0u; asm volatile("" : "+s"(z)); return (int)__builtin_amdgcn_mbcnt_hi(~0u, __builtin_amdgcn_mbcnt_lo(~0u, z)); }
DI int sh_bperm(int idx, int v) { return __builtin_amdgcn_ds_bpermute(idx << 2, v); }
DI float my_shfl_xor(float v, int m) { return __builtin_bit_cast(float, sh_bperm((lane_id_fresh() ^ m) & 63, __builtin_bit_cast(int, v))); }
DI unsigned my_shfl_xor(unsigned v, int m) { return (unsigned)sh_bperm((lane_id_fresh() ^ m) & 63, (int)v); }
DI float my_shfl_up(float v, int d) { const int l = lane_id_fresh(); return __builtin_bit_cast(float, sh_bperm(l >= d ? l - d : l, __builtin_bit_cast(int, v))); }
DI float my_shfl(float v, int s) { return __builtin_bit_cast(float, sh_bperm(s & 63, __builtin_bit_cast(int, v))); }
#define __shfl_xor my_shfl_xor
#define __shfl_up my_shfl_up
#define __shfl my_shfl
DI float wave_sum(float v) { v = row16_sum(v); v += __shfl_xor(v, 16); v += __shfl_xor(v, 32); return v; }
DI float half_sum(float v) { v = row16_sum(v); v += __shfl_xor(v, 16); return v; }
DI s16x4 tr_read(const LAS void* p) { return __builtin_bit_cast(s16x4, __builtin_amdgcn_ds_read_tr16_b64_v4i16((LAS v4i16_t*)p)); }
DI f32x16 mfma32(bf16x8 a, bf16x8 b, f32x16 c) { return __builtin_amdgcn_mfma_f32_32x32x16_bf16(a, b, c, 0, 0, 0); }
DI f32x4 mfma16(bf16x8 a, bf16x8 b, f32x4 c) { return __builtin_amdgcn_mfma_f32_16x16x32_bf16(a, b, c, 0, 0, 0); }
DI f32x16 zero16() { f32x16 z; for (int i = 0; i < 16; ++i) z[i] = 0.f; return z; }

struct Ctx {
    LAS unsigned char* lds;
    int tid, lane, wave, G, vcu;
    const float* const __attribute__((address_space(4)))* kin;
    GAS float* out; GAS unsigned char* ws;
};
DI int src_col_in(int r) {
    if (r < 1024) return r;
    if (r < 2048) return 2048 + (r - 1024);
    if (r < 3072) return 3072 + (r - 2048);
    if (r < 7168) return 4096 + (r - 3072);
    if (r < 9216) return 8208 + (r - 7168);
    if (r < 12288) return 10256 + (r - 9216);
    const int q = r - 12288;
    if (q < 1024) return 1024 + q;
    if (q < 1032) return 8192 + (q - 1024);
    if (q < 1040) return 8200 + (q - 1032);
    if (q < 1088) return 13328 + (q - 1040);
    return -1;
}
constexpr int P0_NG[5] = {8, 8, 8, (FF / 64 + 7) / 8, 4};
constexpr int P0_NI[5] = {8 * (NINP / 64), 8 * 64, 8 * (2 * FF / 64), ((FF / 64 + 7) / 8) * 64, 64};
struct P0Addr { const float* src; bf16_t* dst; float keep; };
template <int MAT> DI P0Addr p0_addr(const Ctx& C, int l, int q, int wave, int lane) {
    constexpr int NG = P0_NG[MAT];
    const int n4 = 4 * (lane & 15), kr0 = 64 * wave + 16 * (lane >> 4); P0Addr a; a.keep = 1.0f;
    if (MAT == 0) { const int g = q % NG, nb = q / NG; const int sc = src_col_in(nb * 64 + n4); a.keep = sc >= 0 ? 1.0f : 0.0f;
        a.src = C.kin[IN_W_IN] + (size_t)l * DM * NIN + (size_t)(g * 512 + kr0) * NIN + (sc < 0 ? 0 : sc); a.dst = (bf16_t*)(C.ws + WS_WIN_L(l)) + (size_t)(nb * 64 + 8 * wave) * DM + g * 512 + 8 * lane; }
    else if (MAT == 1) { const int g = q % NG, nb = q / NG;
        a.src = C.kin[IN_W_OUT] + (size_t)l * DM * DM + (size_t)(g * 512 + kr0) * DM + nb * 64 + n4; a.dst = (bf16_t*)(C.ws + WS_WOUT) + (size_t)(nb * 64 + 8 * wave) * DM + g * 512 + 8 * lane; }
    else if (MAT == 2) { const int g = q % NG, nb = q / NG; const int n = nb * 64 + n4, p = n >> 8, within = n & 255;
        const float* base = (within >> 7) ? C.kin[IN_W_UP] : C.kin[IN_W_GATE];
        a.src = base + (size_t)l * DM * FF + (size_t)(g * 512 + kr0) * FF + p * 128 + (within & 127); a.dst = (bf16_t*)(C.ws + WS_WGU) + (size_t)(nb * 64 + 8 * wave) * DM + g * 512 + 8 * lane; }
    else if (MAT == 3) { const int g = q % NG, nb = q / NG; const bool part = (g == NG - 1);
        const int kr = part ? (kr0 & 255) : kr0, kl = part ? (8 * lane) & 255 : 8 * lane;
        a.src = C.kin[IN_W_DOWN] + (size_t)l * FF * DM + (size_t)(g * 512 + kr) * DM + nb * 64 + n4; a.dst = (bf16_t*)(C.ws + WS_WD) + (size_t)(nb * 64 + 8 * wave) * FF + g * 512 + kl; }
    else { const int mi = q >> 4, kv = mi >> 1, half = mi & 1, g = q & 3, nb = (q >> 2) & 3;
        const float* w1 = (kv ? C.kin[IN_W1_V] : C.kin[IN_W1_K]) + (size_t)l * 4096 * 256 + (size_t)half * 2048 * 256;
        a.src = w1 + (size_t)(g * 512 + kr0) * 256 + nb * 64 + n4; a.dst = (bf16_t*)(C.ws + WS_W1CAT) + ((size_t)kv * 512 + half * 256 + nb * 64 + 8 * wave) * 2048 + g * 512 + 8 * lane; }
    return a;
}
constexpr int P0_FILL_DN2 = 288;
constexpr int P0_AHEAD_A = 1000, P0_AHEAD_B = 1696;
constexpr int P0_LAST_GU = 1000;
constexpr int P0_FILL_DN = 512;
template <int MAT, int MODE> DI void p0_mat(const Ctx& C, int l, int qb, int qe, int first, int stride, int& par) {
    constexpr int TP = 516;
    constexpr size_t LDS_ = (MAT == 0) ? NIN : (MAT == 2) ? FF : (MAT == 4) ? 256 : DM;
    constexpr size_t LDD_ = (MAT == 3) ? FF : (MAT == 4) ? 2048 : DM;
    LAS bf16_t* tb0 = (LAS bf16_t*)C.lds; LAS bf16_t* tb1 = tb0 + 64 * TP;
    const int lane = C.lane, wave = C.wave, G = C.G;
    int q = qb + first; (void)G;
    if (q >= qe) return;
    P0Addr cur = p0_addr<MAT>(C, l, q, wave, lane);
    f32x4 vn[16];
#pragma unroll
    for (int i = 0; i < 16; ++i) vn[i] = (MODE != 2) ? __builtin_nontemporal_load((const f32x4*)(cur.src + (size_t)i * LDS_)) : (f32x4){1.f, 2.f, 3.f, 4.f};
    for (; q < qe; q += stride) {
        f32x4 v[16];
#pragma unroll
        for (int i = 0; i < 16; ++i) v[i] = vn[i] * cur.keep;
        if (MAT == 0 || MAT == 2) {
            const float* nw = C.kin[MAT == 0 ? IN_ATTN_NORM : IN_FFN_NORM] + (size_t)l * DM + (q % P0_NG[MAT]) * 512 + 64 * wave + 16 * (lane >> 4);
#pragma unroll
            for (int i4 = 0; i4 < 4; ++i4) { const f32x4 w4 = *(const f32x4*)(nw + 4 * i4); v[4 * i4] = v[4 * i4] * w4[0]; v[4 * i4 + 1] = v[4 * i4 + 1] * w4[1]; v[4 * i4 + 2] = v[4 * i4 + 2] * w4[2]; v[4 * i4 + 3] = v[4 * i4 + 3] * w4[3]; } }
        const int qn = (q + stride < qe) ? q + stride : q; const P0Addr nxt = p0_addr<MAT>(C, l, qn, wave, lane);
        if (MODE != 2) {
#pragma unroll
            for (int i = 0; i < 16; ++i) vn[i] = __builtin_nontemporal_load((const f32x4*)(nxt.src + (size_t)i * LDS_)); }
        LAS bf16_t* tb = par ? tb1 : tb0;
        { const int m = lane & 15, kl = 64 * wave + 16 * (lane >> 4);
#pragma unroll
          for (int kk = 0; kk < 4; ++kk)
#pragma unroll
              for (int j = 0; j < 4; ++j) { u32x2 o; o.x = pk2(v[4 * kk][j], v[4 * kk + 1][j]); o.y = pk2(v[4 * kk + 2][j], v[4 * kk + 3][j]);
                  *(LAS u32x2*)(tb + (4 * m + j) * TP + kl + 4 * kk) = o; } }
        asm volatile("s_waitcnt lgkmcnt(0)" ::: "memory"); __builtin_amdgcn_s_barrier(); asm volatile("" ::: "memory");
        { const int kl = (MAT == 3 && (q % P0_NG[MAT]) == P0_NG[MAT] - 1) ? (8 * lane) & 255 : 8 * lane;
#pragma unroll
          for (int rr = 0; rr < 8; ++rr) { const LAS u32x2* sp = (const LAS u32x2*)(tb + (8 * wave + rr) * TP + kl); const u32x2 a = sp[0], b2 = sp[1];
              u32x4 o; o.x = a.x; o.y = a.y; o.z = b2.x; o.w = b2.y;
              if (MODE != 1) *(u32x4*)(cur.dst + (size_t)rr * LDD_) = o; else asm volatile("" :: "v"(o)); } }
        cur = nxt; par ^= 1;
    }
}
template <int MAT> DI void p0_mat2(const Ctx& C, int l, int qb, int qe, int first, int stride, int& par) {
    constexpr int TP = 516;
    constexpr size_t LDS_ = (MAT == 0) ? NIN : (MAT == 2) ? FF : (MAT == 4) ? 256 : DM;
    constexpr size_t LDD_ = (MAT == 3) ? FF : (MAT == 4) ? 2048 : DM;
    LAS bf16_t* tb0 = (LAS bf16_t*)C.lds; LAS bf16_t* tb1 = tb0 + 64 * TP;
    const int lane = C.lane, wave = C.wave;
    int q = qb + first;
    if (q >= qe) return;
    LAS float* nwl = (LAS float*)(C.lds + 2 * 64 * TP * 2);
    if (MAT == 0 || MAT == 2) { const float* nw = C.kin[MAT == 0 ? IN_ATTN_NORM : IN_FFN_NORM] + (size_t)l * DM + (q % P0_NG[MAT]) * 512;
        nwl[C.tid] = nw[C.tid]; asm volatile("s_waitcnt vmcnt(0) lgkmcnt(0)" ::: "memory"); __builtin_amdgcn_s_barrier(); asm volatile("" ::: "memory"); }
    P0Addr a0 = p0_addr<MAT>(C, l, q, wave, lane), a1 = p0_addr<MAT>(C, l, (q + stride < qe) ? q + stride : q, wave, lane);
    f32x4 SA[16], SB[16];
#pragma unroll
    for (int i = 0; i < 16; ++i) SA[i] = __builtin_nontemporal_load((const f32x4*)(a0.src + (size_t)i * LDS_));
#pragma unroll
    for (int i = 0; i < 16; ++i) SB[i] = __builtin_nontemporal_load((const f32x4*)(a1.src + (size_t)i * LDS_));
#define P0_PROCESS(S, cur, qq, nxt) do { \
        f32x4 v[16]; \
        _Pragma("unroll") for (int i = 0; i < 16; ++i) v[i] = S[i] * cur.keep; \
        if (MAT == 0 || MAT == 2) { \
            const LAS float* nwp = nwl + 64 * wave + 16 * (lane >> 4); \
            _Pragma("unroll") for (int i4 = 0; i4 < 4; ++i4) { const f32x4 w4 = *(const LAS f32x4*)(nwp + 4 * i4); v[4 * i4] = v[4 * i4] * w4[0]; v[4 * i4 + 1] = v[4 * i4 + 1] * w4[1]; v[4 * i4 + 2] = v[4 * i4 + 2] * w4[2]; v[4 * i4 + 3] = v[4 * i4 + 3] * w4[3]; } } \
        _Pragma("unroll") for (int i = 0; i < 16; ++i) S[i] = __builtin_nontemporal_load((const f32x4*)(nxt.src + (size_t)i * LDS_)); \
        LAS bf16_t* tb = par ? tb1 : tb0; \
        { const int m = lane & 15, kl = 64 * wave + 16 * (lane >> 4); \
          _Pragma("unroll") for (int kk = 0; kk < 4; ++kk) \
              _Pragma("unroll") for (int j = 0; j < 4; ++j) { u32x2 o; o.x = pk2(v[4 * kk][j], v[4 * kk + 1][j]); o.y = pk2(v[4 * kk + 2][j], v[4 * kk + 3][j]); \
                  *(LAS u32x2*)(tb + (4 * m + j) * TP + kl + 4 * kk) = o; } } \
        asm volatile("s_waitcnt lgkmcnt(0)" ::: "memory"); __builtin_amdgcn_s_barrier(); asm volatile("" ::: "memory"); \
        { const int kl = (MAT == 3 && ((qq) % P0_NG[MAT]) == P0_NG[MAT] - 1) ? (8 * lane) & 255 : 8 * lane; \
          _Pragma("unroll") for (int rr = 0; rr < 8; ++rr) { const LAS u32x2* sp = (const LAS u32x2*)(tb + (8 * wave + rr) * TP + kl); const u32x2 a = sp[0], b2 = sp[1]; \
              u32x4 o; o.x = a.x; o.y = a.y; o.z = b2.x; o.w = b2.y; \
              *(u32x4*)(cur.dst + (size_t)rr * LDD_) = o; } } \
        par ^= 1; } while (0)
    for (; q < qe; q += 2 * stride) {
        const P0Addr a2 = p0_addr<MAT>(C, l, (q + 2 * stride < qe) ? q + 2 * stride : q, wave, lane);
        P0_PROCESS(SA, a0, q, a2);
        if (q + stride >= qe) break;
        const P0Addr a3 = p0_addr<MAT>(C, l, (q + 3 * stride < qe) ? q + 3 * stride : q, wave, lane);
        P0_PROCESS(SB, a1, q + stride, a3);
        a0 = a2; a1 = a3;
    }
#undef P0_PROCESS
}
DI void phase_tables(const Ctx& C) {
    float* cosT = (float*)(C.ws + WS_ROPE_C); float* sinT = (float*)(C.ws + WS_ROPE_S);
    for (int idx = C.vcu * 512 + C.tid; idx < T * 64; idx += C.G * 512) { const int t = idx >> 6, i = idx & 63;
        const float inv = (float)pow(10000.0, -(double)(2 * i) / 128.0); const float ang = (float)t * inv;
        cosT[idx] = (float)cos((double)ang); sinT[idx] = (float)sin((double)ang); }
}
template <int MODE> DI void phase_p0_t(const Ctx& C, int l) {
    const int lane = C.lane, gw = C.vcu * 8 + C.wave, NGW = C.G * 8; int par = 0;
    const bool fill = (C.G == 256); const int G = C.G; int B = 0;
#define P0_RANGE(MAT, qb, qe) do { p0_mat<MAT, MODE>(C, l, qb, qe, ((C.vcu - B) % G + G) % G, G, par); B += (qe) - (qb); } while (0)
    P0_RANGE(0, ((fill && l > 0) ? P0_AHEAD_B : 0), P0_NI[0]);
    if (!fill) P0_RANGE(1, 0, P0_NI[1]);
    const bool last = fill && (l + 1 == DEPTH);
    P0_RANGE(2, (last ? P0_LAST_GU : 0), P0_NI[2]);
    if (!last) P0_RANGE(3, (fill ? P0_FILL_DN + P0_FILL_DN2 : 0), P0_NI[3]);
    P0_RANGE(4, 0, P0_NI[4]);
#undef P0_RANGE
    asm volatile("s_waitcnt lgkmcnt(0)" ::: "memory"); __builtin_amdgcn_s_barrier(); asm volatile("" ::: "memory");
    if (MODE != 0) return;
    { bf16_t* W2T = (bf16_t*)(C.ws + WS_W2T);
      for (int t = C.vcu * 512 + C.tid; t < 2 * 128 * 32; t += C.G * 512) { const int kv = t >> 12, d = t & 127, k0 = ((t >> 7) & 31) * 8;
          const float* w2 = (kv ? C.kin[IN_W2_V] : C.kin[IN_W2_K]) + (size_t)l * 256 * 128 + (size_t)k0 * 128 + d;
          u32x4 o; o.x = pk2(w2[0], w2[128]); o.y = pk2(w2[256], w2[384]); o.z = pk2(w2[512], w2[640]); o.w = pk2(w2[768], w2[896]);
          *(u32x4*)(W2T + ((size_t)kv * 128 + d) * 256 + k0) = o; } }
    { const int t = C.G - 1 - C.vcu;
      if (t < 16) { const int kv = t >> 3, rng = t & 7, wave = C.wave;
          const float* pos = (kv ? C.kin[IN_POS_V] : C.kin[IN_POS_K]) + (size_t)l * 4096 + rng * 512 + wave * 64;
          const float* w1 = (kv ? C.kin[IN_W1_V] : C.kin[IN_W1_K]) + (size_t)l * 4096 * 256 + (size_t)(rng * 512 + wave * 64) * 256 + 4 * lane;
          f32x4 acc = {0.f, 0.f, 0.f, 0.f};
#pragma unroll 16
          for (int i = 0; i < 64; ++i) acc += pos[i] * *(const f32x4*)(w1 + (size_t)i * 256);
          LAS float* red = (LAS float*)C.lds;
          *(LAS f32x4*)(red + wave * 256 + 4 * lane) = acc;
          __syncthreads();
          if (C.tid < 256) { float sum = 0.f;
#pragma unroll
              for (int w = 0; w < 8; ++w) sum += red[w * 256 + C.tid];
              ((float*)(C.ws + WS_C1))[(kv * 8 + rng) * 256 + C.tid] = sum; }
          __syncthreads(); } }
    (void)gw; (void)NGW;
}
DI void phase_p0(const Ctx& C, int l) { phase_p0_t<0>(C, l); }
constexpr int P0_NDED = 8, P0_DED_X = 400;
DI void p0_fill_in_ded(const Ctx& C, int l, int f, int F) { int par = 0; p0_mat2<1>(C, l, 0, P0_NI[1], f, F, par); p0_mat2<3>(C, l, P0_FILL_DN, P0_FILL_DN + P0_FILL_DN2, f, F, par);
    if (l + 1 < DEPTH) p0_mat2<0>(C, l + 1, 0, P0_DED_X, f, F, par); else p0_mat2<2>(C, l, 0, P0_DED_X, f, F, par);
    asm volatile("s_waitcnt lgkmcnt(0)" ::: "memory"); __builtin_amdgcn_s_barrier(); asm volatile("" ::: "memory"); }
DI void p0_fill_in_tail(const Ctx& C, int l, int f, int F) { int par = 0;
    if (l + 1 < DEPTH) p0_mat2<0>(C, l + 1, P0_DED_X, P0_AHEAD_A, f, F, par); else p0_mat2<2>(C, l, P0_DED_X, P0_LAST_GU, f, F, par);
    asm volatile("s_waitcnt lgkmcnt(0)" ::: "memory"); __builtin_amdgcn_s_barrier(); asm volatile("" ::: "memory"); }
DI void p0_fill_wdown(const Ctx& C, int l, int f, int F) { int par = 0; p0_mat2<3>(C, l, 0, P0_FILL_DN, f, F, par); if (l + 1 < DEPTH) p0_mat2<0>(C, l + 1, P0_AHEAD_A, P0_AHEAD_B, f, F, par); else p0_mat2<3>(C, l, P0_FILL_DN + P0_FILL_DN2, P0_NI[3], f, F, par); asm volatile("s_waitcnt lgkmcnt(0)" ::: "memory"); __builtin_amdgcn_s_barrier(); asm volatile("" ::: "memory"); }
DI void phase_xcvt(const Ctx& C, const float* x, bf16_t* outb, unsigned long long* rs) {
    const int gw = C.vcu * 8 + C.wave, NGW = C.G * 8, lane = C.lane;
    for (int row = gw; row < M; row += NGW) {
        const f32x4* xr = (const f32x4*)(x + (size_t)row * DM) + lane; float s = 0.f;
#pragma unroll
        for (int j = 0; j < 16; ++j) { const f32x4 v = xr[64 * j]; s += (v[0] * v[0] + v[1] * v[1]) + (v[2] * v[2] + v[3] * v[3]);
            u32x2 o; o.x = pk2(v[0], v[1]); o.y = pk2(v[2], v[3]); *(u32x2*)(outb + (size_t)row * DM + 4 * (lane + 64 * j)) = o; }
        s = wave_sum(s); if (lane == 0) rs[row] = (unsigned long long)(s * 1048576.0f + 0.5f);
    }
}
DI void phase_final_norm(const Ctx& C, const bf16_t* x, const float* w, float* outf) {
    const int gw = C.vcu * 8 + C.wave, NGW = C.G * 8, lane = C.lane;
    for (int row = gw; row < M; row += NGW) {
        const u32x4* xr = (const u32x4*)(x + (size_t)row * DM) + lane;
        float v[8][8]; float s = 0.f;
#pragma unroll
        for (int j = 0; j < 8; ++j) { const u32x4 q = xr[64 * j]; v[j][0] = bflo(q.x); v[j][1] = bfhi(q.x); v[j][2] = bflo(q.y); v[j][3] = bfhi(q.y); v[j][4] = bflo(q.z); v[j][5] = bfhi(q.z); v[j][6] = bflo(q.w); v[j][7] = bfhi(q.w);
#pragma unroll
            for (int e = 0; e < 8; ++e) s += v[j][e] * v[j][e]; }
        const float r = 1.0f / sqrtf(wave_sum(s) * (1.0f / DM) + NORM_EPS);
#pragma unroll
        for (int j = 0; j < 8; ++j) { const size_t c0 = (size_t)8 * (lane + 64 * j); const f32x4 w0 = *(const f32x4*)(w + c0), w1 = *(const f32x4*)(w + c0 + 4);
            __builtin_nontemporal_store((f32x4){v[j][0] * r * w0[0], v[j][1] * r * w0[1], v[j][2] * r * w0[2], v[j][3] * r * w0[3]}, (f32x4*)(outf + (size_t)row * DM + c0));
            __builtin_nontemporal_store((f32x4){v[j][4] * r * w1[0], v[j][5] * r * w1[1], v[j][6] * r * w1[2], v[j][7] * r * w1[3]}, (f32x4*)(outf + (size_t)row * DM + c0 + 4)); }
    }
}
template <bool BF> DI void phase_rmsnorm(const Ctx& C, const float* x, const float* w, bf16_t* outb, float* outf) {
    const int gw = C.vcu * 8 + C.wave, NGW = C.G * 8, lane = C.lane;
    for (int row = gw; row < M; row += NGW) {
        const f32x4* xr = (const f32x4*)(x + (size_t)row * DM) + lane;
        f32x4 v[16]; float s = 0.f;
#pragma unroll
        for (int j = 0; j < 16; ++j) { v[j] = xr[64 * j]; s += (v[j][0] * v[j][0] + v[j][1] * v[j][1]) + (v[j][2] * v[j][2] + v[j][3] * v[j][3]); }
        const float r = 1.0f / sqrtf(wave_sum(s) * (1.0f / DM) + NORM_EPS);
#pragma unroll
        for (int j = 0; j < 16; ++j) { const f32x4 wv = ((const f32x4*)w)[lane + 64 * j]; const f32x4 y = v[j] * r * wv;
            if (BF) { u32x2 o; o.x = pk2(y[0], y[1]); o.y = pk2(y[2], y[3]); *(u32x2*)(outb + (size_t)row * DM + 4 * (lane + 64 * j)) = o; }
            else *((f32x4*)(outf + (size_t)row * DM) + lane + 64 * j) = y; }
    }
}
DI void phase_rope(const Ctx& C, float sgn = 1.0f) {
    const int gw = C.vcu * 8 + C.wave, NGW = C.G * 8, lane = C.lane;
    bf16_t* Ybf = (bf16_t*)(C.ws + WS_YBF); bf16_t* KCV = (bf16_t*)(C.ws + WS_KCV);
    const float* cosT = (const float*)(C.ws + WS_ROPE_C); const float* sinT = (const float*)(C.ws + WS_ROPE_S);
    { unsigned long long* rsa = (unsigned long long*)(C.ws + WS_RSA); unsigned long long* rsb = (unsigned long long*)(C.ws + WS_RSB);
      for (int i = C.vcu * 512 + C.tid; i < M; i += C.G * 512) { rsa[i] = 0ull; rsb[i] = 0ull; } }
    const int hs = lane >> 5, p2 = 2 * (lane & 31);
    for (int row = gw; row < M; row += NGW) {
        const int b = row / T, t = row - b * T;
        const f32x2 cs = *(const f32x2*)(cosT + t * 64 + p2), sn = *(const f32x2*)(sinT + t * 64 + p2) * sgn;
        bf16_t* yr = Ybf + (size_t)row * LDY;
#pragma unroll
        for (int i = 8; i < 14; ++i) { const int hv = 2 * i + hs;
            int col; if (hv < 16) col = Y_NQ + hv * 128; else if (hv < 20) col = Y_KC + (hv - 16) * 128; else if (hv < 24) col = Y_KS + (hv - 20) * 128; else col = Y_KW + (hv - 24) * 128;
            const unsigned a = *(const unsigned*)(yr + col + p2), bb = *(const unsigned*)(yr + col + 64 + p2);
            const float x1a = bflo(a), x1b = bfhi(a), x2a = bflo(bb), x2b = bfhi(bb);
            const unsigned o1 = pk2(x1a * cs[0] - x2a * sn[0], x1b * cs[1] - x2b * sn[1]), o2 = pk2(x2a * cs[0] + x1a * sn[0], x2b * cs[1] + x1b * sn[1]);
            bf16_t* dst = yr + col;
            if (hv >= 16 && hv < 20) dst = KCV + ((size_t)(b * 4 + (hv - 16)) * T + t) * 128;
            *(unsigned*)(dst + p2) = o1; *(unsigned*)(dst + 64 + p2) = o2; }
        { const u32x4 v = *(const u32x4*)(yr + Y_VC + lane * 8); const int g = lane >> 4, d = (lane & 15) * 8;
            *(u32x4*)(KCV + ((size_t)(16 + b * 4 + g) * T + t) * 128 + d) = v; }
    }
}
DI void hgrn_pre_unit(const Ctx& C, int l, int u) {
    const int tid = C.tid, lane = C.lane, wave = C.wave;
    const int b = u >> 8, h = (u >> 5) & 7, c = u & 31, row0 = b * T + 64 * c;
    const bf16_t* Ybf = (const bf16_t*)(C.ws + WS_YBF); const float* Yf = (const float*)(C.ws + WS_YF);
    LAS float* Bc = (LAS float*)(C.lds);
    LAS float* Kf = (LAS float*)(C.lds + 32768);
    LAS bf16_t* Qt = (LAS bf16_t*)(C.lds + 65536);
    LAS bf16_t* Kt = (LAS bf16_t*)(C.lds + 82944);
    bf16_t* HQD = (bf16_t*)(C.ws + WS_H_QD) + (size_t)u * 8192; bf16_t* HKDT = (bf16_t*)(C.ws + WS_H_KDT) + (size_t)u * 8192;
    bf16_t* HATT = (bf16_t*)(C.ws + WS_H_ATT) + (size_t)u * 4096; bf16_t* HVT = (bf16_t*)(C.ws + WS_H_VT) + (size_t)u * 8192; float* HDEC = (float*)(C.ws + WS_H_DEC) + (size_t)u * 128;
    { const int d = tid & 127, seg = tid >> 7; float lb = 0.f;
      LAS float* segtot = (LAS float*)(C.lds + 117760);
      if (l == 1) { const float x0 = C.kin[IN_LB][h * 128 + d], x1 = C.kin[IN_LB][1024 + h * 128 + d]; lb = 1.0f / (1.0f + __expf(x1 - x0)); }
      float fpv[16];
#pragma unroll
      for (int i = 0; i < 16; ++i) fpv[i] = Yf[(size_t)(row0 + 16 * seg + i) * LDF + F_HF + h * 128 + d];
      float pre[16]; float run = 0.f;
#pragma unroll
      for (int i = 0; i < 16; ++i) { const float fp = fpv[i];
          const float e = __expf(-fabsf(fp)); const float r = 1.0f / (1.0f + e); const float sp = (fp >= 0.f) ? r : e * r, sm = (fp >= 0.f) ? e * r : r;
          const float kf = (1.0f - lb) * sm, f = lb + (1.0f - lb) * sp;
          const float lf = (kf < 0.125f) ? -kf * (1.0f + kf * (0.5f + kf * (0.33333334f + kf * (0.25f + kf * (0.2f + kf * 0.16666667f))))) : __logf(fmaxf(f, 1e-38f));
          run += fminf(lf, 0.f); pre[i] = run; Kf[(16 * seg + i) * 128 + d] = kf; }
      segtot[seg * 128 + d] = run;
      __syncthreads();
      float off = 0.f;
#pragma unroll
      for (int s2 = 0; s2 < 3; ++s2) off += (s2 < seg) ? segtot[s2 * 128 + d] : 0.f;
#pragma unroll
      for (int i = 0; i < 16; ++i) Bc[(16 * seg + i) * 128 + d] = pre[i] + off; }
    __syncthreads();
#pragma unroll
    for (int i = 0; i < 2; ++i) { const int task = tid + 512 * i, s = task >> 4, d0 = (task & 15) * 8;
        const u32x4 qw = *(const u32x4*)(Ybf + (size_t)(row0 + s) * LDY + Y_HQ + h * 128 + d0);
        float q[8]; q[0] = bflo(qw.x); q[1] = bfhi(qw.x); q[2] = bflo(qw.y); q[3] = bfhi(qw.y); q[4] = bflo(qw.z); q[5] = bfhi(qw.z); q[6] = bflo(qw.w); q[7] = bfhi(qw.w);
        float qd[8], qt[8], kt[8];
#pragma unroll
        for (int j = 0; j < 8; ++j) { const float qq = silu_f(q[j]); const float bb = Bc[s * 128 + d0 + j], bm = Bc[32 * 128 + d0 + j], kk = Kf[s * 128 + d0 + j];
            qd[j] = qq * __expf(bb); qt[j] = qq * __expf(fminf(bb - bm, 80.f)); kt[j] = kk * __expf(fminf(bm - bb, 80.f)); }
        u32x4 o; o.x = pk2(qd[0], qd[1]); o.y = pk2(qd[2], qd[3]); o.z = pk2(qd[4], qd[5]); o.w = pk2(qd[6], qd[7]);
        *(u32x4*)(HQD + s * 128 + d0) = o;
        o.x = pk2(qt[0], qt[1]); o.y = pk2(qt[2], qt[3]); o.z = pk2(qt[4], qt[5]); o.w = pk2(qt[6], qt[7]);
        *(LAS u32x4*)(Qt + s * 136 + d0) = o;
        o.x = pk2(kt[0], kt[1]); o.y = pk2(kt[2], kt[3]); o.z = pk2(kt[4], kt[5]); o.w = pk2(kt[6], kt[7]);
        *(LAS u32x4*)(Kt + s * 136 + d0) = o; }
#pragma unroll
    for (int i = 0; i < 2; ++i) { const int task = tid + 512 * i, d = task & 127, s0 = (task >> 7) * 8;
        const float bl = Bc[63 * 128 + d]; float kv[8], vv[8];
#pragma unroll
        for (int j = 0; j < 8; ++j) { kv[j] = Kf[(s0 + j) * 128 + d] * __expf(bl - Bc[(s0 + j) * 128 + d]); vv[j] = bf2f(Ybf[(size_t)(row0 + s0 + j) * LDY + Y_HI + h * 128 + d]); }
        u32x4 o; o.x = pk2(kv[0], kv[1]); o.y = pk2(kv[2], kv[3]); o.z = pk2(kv[4], kv[5]); o.w = pk2(kv[6], kv[7]);
        *(u32x4*)(HKDT + d * 64 + s0) = o;
        o.x = pk2(vv[0], vv[1]); o.y = pk2(vv[2], vv[3]); o.z = pk2(vv[4], vv[5]); o.w = pk2(vv[6], vv[7]);
        *(u32x4*)(HVT + d * 64 + s0) = o; }
    if (tid < 128) HDEC[tid] = __expf(Bc[63 * 128 + tid]);
    __syncthreads();
    if (wave < 4) { const int tt = wave >> 1, st = wave & 1, r31 = lane & 31, hh = lane >> 5;
        f32x16 acc = zero16();
#pragma unroll
        for (int ks = 0; ks < 8; ++ks) { const bf16x8 a = *(const LAS bf16x8*)(Qt + (32 * tt + r31) * 136 + 16 * ks + 8 * hh), bb = *(const LAS bf16x8*)(Kt + (32 * st + r31) * 136 + 16 * ks + 8 * hh);
            acc = mfma32(a, bb, acc); }
        const int s = 32 * st + r31;
#pragma unroll
        for (int r = 0; r < 16; ++r) { const int t = 32 * tt + (r & 3) + 8 * (r >> 2) + 4 * hh; const float v = (s <= t) ? acc[r] : 0.f; HATT[t * 64 + s] = f2bf(v); } }
    __syncthreads();
}
template <bool STORE> DI void gdn_solve(LAS float* RHS, LAS float* Mx, LAS bf16_t* KdT, float* GUT, bf16_t* GW, bf16_t* GKDT, int tid) {
    const int lane = tid & 63, wave = tid >> 6, r15 = lane & 15, kq = lane >> 4;
#pragma unroll
    for (int bi = 0; bi < 4; ++bi) {
        if (bi > 0) {
#pragma unroll
            for (int ct2 = 0; ct2 < 2; ++ct2) { const int ct = 2 * wave + ct2; f32x4 acc = {0.f, 0.f, 0.f, 0.f};
#pragma unroll
                for (int kk = 0; kk < 4 * bi; ++kk) acc = __builtin_amdgcn_mfma_f32_16x16x4f32(Mx[(4 * kk + kq) * 68 + 16 * bi + r15], RHS[(4 * kk + kq) * 256 + 16 * ct + r15], acc, 0, 0, 0);
#pragma unroll
                for (int r = 0; r < 4; ++r) RHS[(16 * bi + 4 * kq + r) * 256 + 16 * ct + r15] -= acc[r]; }
            __syncthreads();
        }
        if (tid < 256) {
            float s[16];
#pragma unroll
            for (int r = 0; r < 16; ++r) s[r] = RHS[(16 * bi + r) * 256 + tid];
#pragma unroll
            for (int j = 0; j < 16; ++j) { const float xj = s[j];
#pragma unroll
                for (int r4 = 0; r4 < 4; ++r4) { const f32x4 m = *(const LAS f32x4*)(Mx + (16 * bi + j) * 68 + 16 * bi + 4 * r4);
#pragma unroll
                    for (int e = 0; e < 4; ++e) if (4 * r4 + e > j) s[4 * r4 + e] -= m[e] * xj; } }
#pragma unroll
            for (int r = 0; r < 16; ++r) RHS[(16 * bi + r) * 256 + tid] = s[r];
            if (tid < 128) {
#pragma unroll
                for (int r4 = 0; r4 < 4; ++r4) if (STORE) *(f32x4*)(GUT + tid * 64 + 16 * bi + 4 * r4) = (f32x4){s[4 * r4], s[4 * r4 + 1], s[4 * r4 + 2], s[4 * r4 + 3]};
            } else {
#pragma unroll
                for (int r = 0; r < 16; ++r) if (STORE) GW[(16 * bi + r) * 128 + (tid - 128)] = f2bf(s[r]);
            }
        } else if (bi == 0) {
#pragma unroll
            for (int i = 0; i < 4; ++i) { const int task = (tid - 256) + 256 * i, d = task >> 3, s0 = (task & 7) * 8;
                if (STORE) *(u32x4*)(GKDT + d * 64 + s0) = *(const LAS u32x4*)(KdT + d * 72 + s0); }
        }
        if (bi < 3) __syncthreads();
    }
}
DI void gdn_pre_unit(const Ctx& C, int l, int u) {
    const int tid = C.tid, lane = C.lane, wave = C.wave;
    const int b = u >> 8, h = (u >> 5) & 7, c = u & 31, row0 = b * T + 64 * c;
    const bf16_t* Ybf = (const bf16_t*)(C.ws + WS_YBF); const float* Yf = (const float*)(C.ws + WS_YF);
    LAS float* RHS = (LAS float*)(C.lds);
    LAS float* Mx = (LAS float*)(C.lds + 65536);
    LAS bf16_t* Qs = (LAS bf16_t*)(C.lds + 82944);
    LAS bf16_t* Ks = (LAS bf16_t*)(C.lds + 100352);
    LAS bf16_t* KdT = (LAS bf16_t*)(C.lds + 117760);
    LAS float* gcL = (LAS float*)(C.lds + 136192);
    LAS float* betaL = gcL + 64; LAS float* egcL = gcL + 128;
    float* GUT = (float*)(C.ws + WS_G_UT) + (size_t)u * 8192; bf16_t* GW = (bf16_t*)(C.ws + WS_G_W) + (size_t)u * 8192; bf16_t* GQD = (bf16_t*)(C.ws + WS_G_QD) + (size_t)u * 8192;
    bf16_t* GKDT = (bf16_t*)(C.ws + WS_G_KDT) + (size_t)u * 8192; bf16_t* GQK = (bf16_t*)(C.ws + WS_G_QK) + (size_t)u * 4096; float* GDL = (float*)(C.ws + WS_G_DL);
    LAS float* CWL = (LAS float*)(C.lds + 137216);
    if (tid < 384) { const int sw = tid >> 5, sec = sw >> 2, w = sw & 3, dq = (tid & 31) * 4;
        *(LAS f32x4*)(CWL + sw * 128 + dq) = *(const f32x4*)(C.kin[IN_CONV] + (size_t)l * 4 * 3072 + w * 3072 + sec * 1024 + h * 128 + dq); }
    float gc_r, beta_r, egc_r, glast;
    { const float* alp = C.kin[IN_ALOG]; const float* dtp = C.kin[IN_DTB];
      const float a_raw = Yf[(size_t)(row0 + lane) * LDF + F_GA + h], b_raw = Yf[(size_t)(row0 + lane) * LDF + F_GB + h], alog = alp[l * 8 + h], dtb = dtp[l * 8 + h];
      float g = -__expf(alog) * softplus_f(a_raw + dtb);
#pragma unroll
      for (int o = 1; o < 64; o <<= 1) { const float t = __shfl_up(g, o); if (lane >= o) g += t; }
      gc_r = g; beta_r = sigmoid_f(b_raw); egc_r = __expf(g); glast = __shfl(g, 63);
      if (wave == 0) { gcL[lane] = g; betaL[lane] = beta_r; egcL[lane] = egc_r; if (lane == 63) GDL[u] = egc_r; } }
    __syncthreads();
    { const int hw = tid >> 5, sub = tid & 31, d0 = 4 * sub;
      const LAS float* cwl = CWL + d0;
      u32x2 xn[3][4];
#define GDN_LOADROW(dst, s_) do { _Pragma("unroll") for (int sec = 0; sec < 3; ++sec) _Pragma("unroll") for (int w = 0; w < 4; ++w) { const int ts = 64 * c + (s_) - 3 + w; \
              dst[sec][w] = *(const u32x2*)(Ybf + (size_t)(b * T + (ts < 0 ? 0 : ts)) * LDY + Y_GQ + sec * 1024 + h * 128 + d0); } } while (0)
      GDN_LOADROW(xn, hw);
#pragma unroll
      for (int i = 0; i < 4; ++i) { const int s = i * 16 + hw;
          u32x2 xw[3][4];
#pragma unroll
          for (int sec = 0; sec < 3; ++sec)
#pragma unroll
              for (int w = 0; w < 4; ++w) { const bool in = (64 * c + s - 3 + w) >= 0; xw[sec][w].x = in ? xn[sec][w].x : 0u; xw[sec][w].y = in ? xn[sec][w].y : 0u; }
          if (i < 3) GDN_LOADROW(xn, s + 16);
          const float bs = __shfl(beta_r, s), eg = __shfl(egc_r, s), f2 = __expf(glast - __shfl(gc_r, s));
#pragma unroll
          for (int sec = 0; sec < 3; ++sec) { float y[4] = {0.f, 0.f, 0.f, 0.f};
#pragma unroll
              for (int w = 0; w < 4; ++w) { const f32x4 cw = *(const LAS f32x4*)(cwl + (sec * 4 + w) * 128);
                  y[0] += bflo(xw[sec][w].x) * cw[0]; y[1] += bfhi(xw[sec][w].x) * cw[1]; y[2] += bflo(xw[sec][w].y) * cw[2]; y[3] += bfhi(xw[sec][w].y) * cw[3]; }
#pragma unroll
              for (int j = 0; j < 4; ++j) y[j] = silu_f(y[j]);
              if (sec < 2) { const float ss = half_sum((y[0] * y[0] + y[1] * y[1]) + (y[2] * y[2] + y[3] * y[3])); float r = __builtin_amdgcn_rsqf(ss + NORM_EPS); if (sec == 0) r *= 0.08838834764831845f;
#pragma unroll
                  for (int j = 0; j < 4; ++j) y[j] *= r; }
              if (sec == 0) { u32x2 o; o.x = pk2(y[0], y[1]); o.y = pk2(y[2], y[3]); *(LAS u32x2*)(Qs + s * 136 + d0) = o;
                  o.x = pk2(y[0] * eg, y[1] * eg); o.y = pk2(y[2] * eg, y[3] * eg); *(u32x2*)(GQD + s * 128 + d0) = o; }
              else if (sec == 1) { u32x2 o; o.x = pk2(y[0], y[1]); o.y = pk2(y[2], y[3]); *(LAS u32x2*)(Ks + s * 136 + d0) = o;
                  const float f1 = bs * eg;
#pragma unroll
                  for (int j = 0; j < 4; ++j) { RHS[s * 256 + 128 + d0 + j] = y[j] * f1; KdT[(d0 + j) * 72 + s] = f2bf(y[j] * f2); } }
              else {
#pragma unroll
                  for (int j = 0; j < 4; ++j) RHS[s * 256 + d0 + j] = y[j] * bs; }
          }
      }
#undef GDN_LOADROW
    }
    __syncthreads();
    { const int kind = wave >> 2, tt = (wave >> 1) & 1, st = wave & 1, r31 = lane & 31, hh = lane >> 5;
      const LAS bf16_t* As = kind ? Qs : Ks;
      f32x16 acc = zero16();
#pragma unroll
      for (int ks = 0; ks < 8; ++ks) { const bf16x8 a = *(const LAS bf16x8*)(As + (32 * tt + r31) * 136 + 16 * ks + 8 * hh), bb = *(const LAS bf16x8*)(Ks + (32 * st + r31) * 136 + 16 * ks + 8 * hh);
          acc = mfma32(a, bb, acc); }
      const int j = 32 * st + r31; const float gj = gcL[j];
#pragma unroll
      for (int r = 0; r < 16; ++r) { const int i = 32 * tt + (r & 3) + 8 * (r >> 2) + 4 * hh;
          if (kind == 0) { Mx[j * 68 + i] = (j < i) ? betaL[i] * acc[r] * __expf(gcL[i] - gj) : 0.f; }
          else { GQK[i * 64 + j] = f2bf((j <= i) ? acc[r] * __expf(gcL[i] - gj) : 0.f); } } }
    __syncthreads();
    gdn_solve<true>(RHS, Mx, KdT, GUT, GW, GKDT, tid);
#if defined(GDN_SOLVE_TWICE)
    __syncthreads(); gdn_solve<false>(RHS, Mx, KdT, GUT, GW, GKDT, tid);
#endif
    __syncthreads();
}
#define BAR_LDS() do { asm volatile("s_waitcnt lgkmcnt(0)" ::: "memory"); __builtin_amdgcn_s_barrier(); asm volatile("" ::: "memory"); } while (0)
DI u32x2 pack4(const f32x4 v) { u32x2 o; o.x = pk2(v[0], v[1]); o.y = pk2(v[2], v[3]); return o; }
struct ScanGA { bf16x8 wfr[4]; f32x4 ut[2]; bf16x8 gk[2][2]; float dl; };
struct ScanGB { bf16x8 gqd[4], gqk[2]; };
struct ScanHA { bf16x8 hk[2][2], hv[2][2]; f32x4 hdec[2]; };
struct ScanHB { bf16x8 hqd[4], hat[2], hv[2][2]; };
DI void scan_load(ScanGA& L, const GAS unsigned char* ws, int u, int sl, int w, int lane) {
    const int r15 = lane & 15, quad = lane >> 4;
    const bf16_t* GW = (const bf16_t*)(ws + WS_G_W) + (size_t)u * 8192; const float* GUT = (const float*)(ws + WS_G_UT) + (size_t)u * 8192; const bf16_t* GKDT = (const bf16_t*)(ws + WS_G_KDT) + (size_t)u * 8192;
#pragma unroll
    for (int ks = 0; ks < 4; ++ks) L.wfr[ks] = *(const bf16x8*)(GW + (16 * w + r15) * 128 + 32 * ks + 8 * quad);
#pragma unroll
    for (int nt = 0; nt < 2; ++nt) L.ut[nt] = *(const f32x4*)(GUT + (sl * 32 + 16 * nt + r15) * 64 + 16 * w + 4 * quad);
#pragma unroll
    for (int t = 0; t < 2; ++t)
#pragma unroll
        for (int ks = 0; ks < 2; ++ks) L.gk[t][ks] = *(const bf16x8*)(GKDT + (32 * w + 16 * t + r15) * 64 + 32 * ks + 8 * quad);
    L.dl = ((const float*)(ws + WS_G_DL))[u];
}
DI void scan_load(ScanGB& L, const GAS unsigned char* ws, int u, int sl, int w, int lane) {
    const int r15 = lane & 15, quad = lane >> 4; (void)sl;
    const bf16_t* GQD = (const bf16_t*)(ws + WS_G_QD) + (size_t)u * 8192; const bf16_t* GQK = (const bf16_t*)(ws + WS_G_QK) + (size_t)u * 4096;
#pragma unroll
    for (int ks = 0; ks < 4; ++ks) L.gqd[ks] = *(const bf16x8*)(GQD + (16 * w + r15) * 128 + 32 * ks + 8 * quad);
#pragma unroll
    for (int ks = 0; ks < 2; ++ks) L.gqk[ks] = *(const bf16x8*)(GQK + (16 * w + r15) * 64 + 32 * ks + 8 * quad);
}
DI void scan_load(ScanHA& L, const GAS unsigned char* ws, int u, int sl, int w, int lane) {
    const int r15 = lane & 15, quad = lane >> 4;
    const bf16_t* HKDT = (const bf16_t*)(ws + WS_H_KDT) + (size_t)u * 8192; const bf16_t* HVT = (const bf16_t*)(ws + WS_H_VT) + (size_t)u * 8192;
#pragma unroll
    for (int t = 0; t < 2; ++t)
#pragma unroll
        for (int ks = 0; ks < 2; ++ks) { L.hk[t][ks] = *(const bf16x8*)(HKDT + (32 * w + 16 * t + r15) * 64 + 32 * ks + 8 * quad); L.hv[t][ks] = *(const bf16x8*)(HVT + (sl * 32 + 16 * t + r15) * 64 + 32 * ks + 8 * quad); }
#pragma unroll
    for (int t = 0; t < 2; ++t) L.hdec[t] = *(const f32x4*)((const float*)(ws + WS_H_DEC) + (size_t)u * 128 + 32 * w + 16 * t + 4 * quad);
}
DI void scan_load(ScanHB& L, const GAS unsigned char* ws, int u, int sl, int w, int lane) {
    const int r15 = lane & 15, quad = lane >> 4;
    const bf16_t* HQD = (const bf16_t*)(ws + WS_H_QD) + (size_t)u * 8192; const bf16_t* HATT = (const bf16_t*)(ws + WS_H_ATT) + (size_t)u * 4096; const bf16_t* HVT = (const bf16_t*)(ws + WS_H_VT) + (size_t)u * 8192;
#pragma unroll
    for (int ks = 0; ks < 4; ++ks) L.hqd[ks] = *(const bf16x8*)(HQD + (16 * w + r15) * 128 + 32 * ks + 8 * quad);
#pragma unroll
    for (int ks = 0; ks < 2; ++ks) { L.hat[ks] = *(const bf16x8*)(HATT + (16 * w + r15) * 64 + 32 * ks + 8 * quad);
#pragma unroll
        for (int nt = 0; nt < 2; ++nt) L.hv[nt][ks] = *(const bf16x8*)(HVT + (sl * 32 + 16 * nt + r15) * 64 + 32 * ks + 8 * quad); }
}
DI void scan_unit(const Ctx& C, int su) {
    const int tid = C.tid, lane = C.lane, wave = C.wave, r15 = lane & 15, quad = lane >> 4;
    const int kind = su >> 7, bh = (su >> 2) & 31, sl = su & 3, b = bh >> 3, h = bh & 7;
    LAS bf16_t* ST = (LAS bf16_t*)(C.lds);
    LAS bf16_t* VN = (LAS bf16_t*)(C.lds + 8704);
    for (int i = tid; i < 8704 / 4; i += 512) ((LAS unsigned*)C.lds)[i] = 0u;
    BAR_LDS();
    bf16_t* OAB = (bf16_t*)(C.ws + WS_OAB);
    const f32x4 z4 = {0.f, 0.f, 0.f, 0.f};
#define ST_FRAG(nt, ks) (*(const LAS bf16x8*)(ST + (16 * (nt) + r15) * 136 + 32 * (ks) + 8 * quad))
#define VN_FRAG(nt, ks) (*(const LAS bf16x8*)(VN + (16 * (nt) + r15) * 72 + 32 * (ks) + 8 * quad))
    if (kind == 0) {
        if (wave < 4) { const int w = wave;
            f32x4 S[2][2] = {{z4, z4}, {z4, z4}};
            ScanGA cur, nxt; scan_load(cur, C.ws, bh * 32, sl, w, lane);
            for (int c = 0; c < NCHUNK; ++c) {
                if (c + 1 < NCHUNK) scan_load(nxt, C.ws, bh * 32 + c + 1, sl, w, lane);
#pragma unroll
                for (int nt = 0; nt < 2; ++nt) { f32x4 acc = z4;
#pragma unroll
                    for (int ks = 0; ks < 4; ++ks) acc = mfma16(cur.wfr[ks], ST_FRAG(nt, ks), acc);
                    *(LAS u32x2*)(VN + (16 * nt + r15) * 72 + 16 * w + 4 * quad) = pack4(cur.ut[nt] - acc); }
                BAR_LDS();
#pragma unroll
                for (int t = 0; t < 2; ++t)
#pragma unroll
                    for (int nt = 0; nt < 2; ++nt) { f32x4 ag = z4;
#pragma unroll
                        for (int ks = 0; ks < 2; ++ks) ag = mfma16(cur.gk[t][ks], VN_FRAG(nt, ks), ag);
                        S[t][nt] = S[t][nt] * cur.dl + ag;
                        *(LAS u32x2*)(ST + (16 * nt + r15) * 136 + 32 * w + 16 * t + 4 * quad) = pack4(S[t][nt]); }
                BAR_LDS();
                if (c + 1 < NCHUNK) cur = nxt; }
        } else { const int w = wave - 4;
            ScanGB cur, nxt; scan_load(cur, C.ws, bh * 32, sl, w, lane);
            for (int c = 0; c < NCHUNK; ++c) {
                if (c + 1 < NCHUNK) scan_load(nxt, C.ws, bh * 32 + c + 1, sl, w, lane);
                f32x4 og[2] = {z4, z4};
#pragma unroll
                for (int nt = 0; nt < 2; ++nt)
#pragma unroll
                    for (int ks = 0; ks < 4; ++ks) og[nt] = mfma16(cur.gqd[ks], ST_FRAG(nt, ks), og[nt]);
                BAR_LDS();
#pragma unroll
                for (int nt = 0; nt < 2; ++nt) {
#pragma unroll
                    for (int ks = 0; ks < 2; ++ks) og[nt] = mfma16(cur.gqk[ks], VN_FRAG(nt, ks), og[nt]);
                    bf16_t* orow = OAB + (size_t)(b * T + 64 * c + 16 * w + 4 * quad) * 2048 + 1024 + h * 128 + sl * 32 + 16 * nt + r15;
#pragma unroll
                    for (int r = 0; r < 4; ++r) orow[(size_t)r * 2048] = f2bf(og[nt][r]); }
                BAR_LDS();
                if (c + 1 < NCHUNK) cur = nxt; }
        }
    } else {
        if (wave < 4) { const int w = wave;
            f32x4 S[2][2] = {{z4, z4}, {z4, z4}};
            ScanHA cur, nxt; scan_load(cur, C.ws, bh * 32, sl, w, lane);
            for (int c = 0; c < NCHUNK; ++c) {
                if (c + 1 < NCHUNK) scan_load(nxt, C.ws, bh * 32 + c + 1, sl, w, lane);
                BAR_LDS();
#pragma unroll
                for (int t = 0; t < 2; ++t)
#pragma unroll
                    for (int nt = 0; nt < 2; ++nt) { f32x4 ah = z4;
#pragma unroll
                        for (int ks = 0; ks < 2; ++ks) ah = mfma16(cur.hk[t][ks], cur.hv[nt][ks], ah);
                        S[t][nt] = S[t][nt] * cur.hdec[t] + ah;
                        *(LAS u32x2*)(ST + (16 * nt + r15) * 136 + 32 * w + 16 * t + 4 * quad) = pack4(S[t][nt]); }
                BAR_LDS();
                if (c + 1 < NCHUNK) cur = nxt; }
        } else { const int w = wave - 4;
            ScanHB cur, nxt; scan_load(cur, C.ws, bh * 32, sl, w, lane);
            for (int c = 0; c < NCHUNK; ++c) {
                if (c + 1 < NCHUNK) scan_load(nxt, C.ws, bh * 32 + c + 1, sl, w, lane);
                f32x4 oh[2] = {z4, z4};
#pragma unroll
                for (int nt = 0; nt < 2; ++nt)
#pragma unroll
                    for (int ks = 0; ks < 4; ++ks) oh[nt] = mfma16(cur.hqd[ks], ST_FRAG(nt, ks), oh[nt]);
                BAR_LDS();
#pragma unroll
                for (int nt = 0; nt < 2; ++nt) {
#pragma unroll
                    for (int ks = 0; ks < 2; ++ks) oh[nt] = mfma16(cur.hat[ks], cur.hv[nt][ks], oh[nt]);
                    bf16_t* orow = OAB + (size_t)(b * T + 64 * c + 16 * w + 4 * quad) * 2048 + h * 128 + sl * 32 + 16 * nt + r15;
#pragma unroll
                    for (int r = 0; r < 4; ++r) orow[(size_t)r * 2048] = f2bf(oh[nt][r]); }
                BAR_LDS();
                if (c + 1 < NCHUNK) cur = nxt; }
        }
    }
#undef ST_FRAG
#undef VN_FRAG
    BAR_LDS();
}
DI void phase_finalize_ab(const Ctx& C, int l) {
    const int gw = C.vcu * 8 + C.wave, NGW = C.G * 8, lane = C.lane, hs = lane >> 5, d0 = 4 * (lane & 31);
    const bf16_t* OAB = (const bf16_t*)(C.ws + WS_OAB); const bf16_t* Ybf = (const bf16_t*)(C.ws + WS_YBF); bf16_t* MIX = (bf16_t*)(C.ws + WS_MIX);
    for (int row = gw; row < M; row += NGW) {
#pragma unroll
        for (int i = 0; i < 8; ++i) { const int hv = 2 * i + hs, side = hv >> 3, h = hv & 7;
            const u32x2 ow = *(const u32x2*)(OAB + (size_t)row * 2048 + hv * 128 + d0); const f32x4 o = {bflo(ow.x), bfhi(ow.x), bflo(ow.y), bfhi(ow.y)};
            const float ss = half_sum((o[0] * o[0] + o[1] * o[1]) + (o[2] * o[2] + o[3] * o[3]));
            const float r = __builtin_amdgcn_rsqf(ss * (1.0f / 128.0f) + NORM_EPS);
            const f32x4 nw = *(const f32x4*)((side ? C.kin[IN_GD_NORM] : C.kin[IN_HG_NORM]) + l * 128 + d0);
            const u32x2 gw2 = *(const u32x2*)(Ybf + (size_t)row * LDY + (side ? Y_GZ : Y_HG) + h * 128 + d0);
            const float g0 = silu_f(bflo(gw2.x)), g1 = silu_f(bfhi(gw2.x)), g2 = silu_f(bflo(gw2.y)), g3 = silu_f(bfhi(gw2.y));
            u32x2 w; w.x = pk2(o[0] * r * nw[0] * g0, o[1] * r * nw[1] * g1); w.y = pk2(o[2] * r * nw[2] * g2, o[3] * r * nw[3] * g3);
            *(u32x2*)(MIX + (size_t)row * DM + hv * 128 + d0) = w; }
    }
}
DI float gelu_tanh(float x) { const float u = 0.7978845608028654f * (x + 0.044715f * x * x * x); return 0.5f * x * (1.0f + tanhf(u)); }
DI void cmp_mlp2_unit(const Ctx& C, int l, int e) {
    const int tid = C.tid, lane = C.lane, wave = C.wave, kv = e >> 7, bg = (e >> 3) & 15, nb = e & 7;
    const bf16_t* PQ = (const bf16_t*)(C.ws + WS_PQ); const float* c1p = (const float*)(C.ws + WS_C1) + kv * 8 * 256;
    LAS bf16_t* Hd = (LAS bf16_t*)C.lds;
    LAS float* c1s = (LAS float*)(C.lds + 16 * 264 * 2);
    if (tid < 256) { float c1 = 0.f;
#pragma unroll
        for (int q = 0; q < 8; ++q) c1 += c1p[q * 256 + tid];
        c1s[tid] = c1; }
    __syncthreads();
    { const int nn = tid >> 5, j0 = (tid & 31) * 8, n = 16 * nb + nn; float hv[8] = {0.f, 0.f, 0.f, 0.f, 0.f, 0.f, 0.f, 0.f};
      if (n <= 126) { const size_t r = (size_t)(kv * 2048 + bg * 128 + n); f32x4 a0 = {0.f, 0.f, 0.f, 0.f}, a1 = a0;
#pragma unroll
          for (int sp = 0; sp < 4; ++sp) { const bf16_t* pp = PQ + (size_t)sp * 4096 * 1024 + r * 1024 + kv * 512 + j0; const bf16_t* qp = pp + 1024 + 256;
              const u32x4 pw = *(const u32x4*)pp, qw = *(const u32x4*)qp;
              a0 += (f32x4){bflo(pw.x) + bflo(qw.x), bfhi(pw.x) + bfhi(qw.x), bflo(pw.y) + bflo(qw.y), bfhi(pw.y) + bfhi(qw.y)};
              a1 += (f32x4){bflo(pw.z) + bflo(qw.z), bfhi(pw.z) + bfhi(qw.z), bflo(pw.w) + bflo(qw.w), bfhi(pw.w) + bfhi(qw.w)}; }
#pragma unroll
          for (int j = 0; j < 4; ++j) { hv[j] = gelu_tanh(a0[j] + c1s[j0 + j]); hv[4 + j] = gelu_tanh(a1[j] + c1s[j0 + 4 + j]); } }
      u32x4 o; o.x = pk2(hv[0], hv[1]); o.y = pk2(hv[2], hv[3]); o.z = pk2(hv[4], hv[5]); o.w = pk2(hv[6], hv[7]);
      *(LAS u32x4*)(Hd + nn * 264 + j0) = o; }
    __syncthreads();
    { const int r15 = lane & 15, quad = lane >> 4; const bf16_t* W2T = (const bf16_t*)(C.ws + WS_W2T) + ((size_t)kv * 128 + 16 * wave + r15) * 256 + 8 * quad;
      bf16x8 bfr[8];
#pragma unroll
      for (int ks = 0; ks < 8; ++ks) bfr[ks] = *(const bf16x8*)(W2T + 32 * ks);
      f32x4 acc = {0.f, 0.f, 0.f, 0.f};
#pragma unroll
      for (int ks = 0; ks < 8; ++ks) acc = mfma16(*(const LAS bf16x8*)(Hd + r15 * 264 + 32 * ks + 8 * quad), bfr[ks], acc);
      bf16_t* dst = (bf16_t*)(C.ws + (kv ? WS_VCMP : WS_KCMP)) + ((size_t)bg * 128 + 16 * nb + 4 * quad) * 128 + 16 * wave + r15;
#pragma unroll
      for (int r = 0; r < 4; ++r) dst[(size_t)r * 128] = f2bf(acc[r]); }
    __syncthreads();
}
constexpr float ATT_SCALE = 0.08838834764831845f;
constexpr float ATT_C2 = ATT_SCALE * 1.4426950408889634f;
constexpr int KP = 136, VP = 160;
DI bf16x8 pack8(const f32x16& x, int s) {
    u32x4 p; p.x = pk2(x[8 * s], x[8 * s + 1]); p.y = pk2(x[8 * s + 2], x[8 * s + 3]); p.z = pk2(x[8 * s + 4], x[8 * s + 5]); p.w = pk2(x[8 * s + 6], x[8 * s + 7]);
    return __builtin_bit_cast(bf16x8, p);
}
DI void pv_step(f32x16 (&O)[4], const LAS bf16_t* Vt, int kb16, bf16x8 pf, int lane) {
    const int hh = lane >> 5, blk = (lane >> 4) & 1, q4 = (lane & 15) >> 2, p4 = lane & 3;
    const LAS bf16_t* base = Vt + (kb16 + 4 * hh + q4) * VP + 16 * blk + 4 * p4;
#pragma unroll
    for (int dt = 0; dt < 4; ++dt) { const s16x4 lo = tr_read(base + 32 * dt), hi = tr_read(base + 8 * VP + 32 * dt);
        const bf16x8 a = __builtin_shufflevector(lo, hi, 0, 1, 2, 3, 4, 5, 6, 7);
        O[dt] = mfma32(a, pf, O[dt]); }
}
DI void rope_q(bf16x8 (&Qf)[8], const float* cosT, const float* sinT, int tok, int hh) {
#pragma unroll
    for (int ks = 0; ks < 4; ++ks) {
        const float* cp = cosT + tok * 64 + 16 * ks + 8 * hh; const float* sp = sinT + tok * 64 + 16 * ks + 8 * hh;
        const f32x4 c0 = *(const f32x4*)cp, c1 = *(const f32x4*)(cp + 4), s0 = *(const f32x4*)sp, s1 = *(const f32x4*)(sp + 4);
        const u32x4 a = __builtin_bit_cast(u32x4, Qf[ks]), b = __builtin_bit_cast(u32x4, Qf[ks + 4]); u32x4 oa, ob;
#define RQ(w, cA, cB, sA, sB) { const float x1a = bflo(a.w), x1b = bfhi(a.w), x2a = bflo(b.w), x2b = bfhi(b.w); oa.w = pk2(x1a * (cA) - x2a * (sA), x1b * (cB) - x2b * (sB)); ob.w = pk2(x2a * (cA) + x1a * (sA), x2b * (cB) + x1b * (sB)); }
        RQ(x, c0[0], c0[1], s0[0], s0[1]) RQ(y, c0[2], c0[3], s0[2], s0[3]) RQ(z, c1[0], c1[1], s1[0], s1[1]) RQ(w, c1[2], c1[3], s1[2], s1[3])
#undef RQ
        Qf[ks] = __builtin_bit_cast(bf16x8, oa); Qf[ks + 4] = __builtin_bit_cast(bf16x8, ob); }
}
DI void cmp_attn_unit(const Ctx& C, int f) {
    const int tid = C.tid, lane = C.lane, wave = C.wave, r31 = lane & 31, hh = lane >> 5;
    const int bg = f >> 5, it = f & 31, b = bg >> 2, g = bg & 3, t0 = 64 * it;
    LAS bf16_t* Kc = (LAS bf16_t*)C.lds;
    LAS bf16_t* Vc = (LAS bf16_t*)(C.lds + 128 * KP * 2);
    LAS float* IMP = (LAS float*)(C.lds + 128 * KP * 2 + 128 * VP * 2);
    const bf16_t* Ybf = (const bf16_t*)(C.ws + WS_YBF);
    { const bf16_t* kg = (const bf16_t*)(C.ws + WS_KCMP) + (size_t)bg * 16384; const bf16_t* vg = (const bf16_t*)(C.ws + WS_VCMP) + (size_t)bg * 16384;
#pragma unroll
      for (int k = 0; k < 4; ++k) { const int piece = tid + 512 * k, row = piece >> 4, ch = piece & 15;
          *(LAS u32x4*)(Kc + row * KP + ch * 8) = *(const u32x4*)(kg + row * 128 + ch * 8); *(LAS u32x4*)(Vc + row * VP + ch * 8) = *(const u32x4*)(vg + row * 128 + ch * 8); } }
    const int head = 4 * g + (wave >> 1), tq = 32 * (wave & 1), tok = t0 + tq + r31;
    bf16x8 Qf[8];
    { const bf16_t* qp = Ybf + (size_t)(b * T + tok) * LDY + Y_NQ + head * 128 + 8 * hh;
#pragma unroll
      for (int ks = 0; ks < 8; ++ks) Qf[ks] = *(const bf16x8*)(qp + 16 * ks); }
    rope_q(Qf, (const float*)(C.ws + WS_ROPE_C), (const float*)(C.ws + WS_ROPE_S), tok, hh);
    __syncthreads();
    f32x16 S[4];
#pragma unroll
    for (int kt = 0; kt < 4; ++kt) { S[kt] = zero16();
#pragma unroll
        for (int ks = 0; ks < 8; ++ks) S[kt] = mfma32(*(const LAS bf16x8*)(Kc + (32 * kt + r31) * KP + 16 * ks + 8 * hh), Qf[ks], S[kt]); }
    float m = -1e30f;
#pragma unroll
    for (int kt = 0; kt < 4; ++kt)
#pragma unroll
        for (int r = 0; r < 16; ++r) { const int n = 32 * kt + (r & 3) + 8 * (r >> 2) + 4 * hh; const bool ok = (n <= 126) && (16 * n + 31 <= tok); const float sc = S[kt][r] * ATT_SCALE; if (ok) m = fmaxf(m, sc); }
    m = fmaxf(m, __shfl_xor(m, 32));
    float sum = 0.f;
#pragma unroll
    for (int kt = 0; kt < 4; ++kt)
#pragma unroll
        for (int r = 0; r < 16; ++r) { const int n = 32 * kt + (r & 3) + 8 * (r >> 2) + 4 * hh; const bool ok = (n <= 126) && (16 * n + 31 <= tok); const float e = ok ? __expf(S[kt][r] * ATT_SCALE - m) : 0.f; S[kt][r] = e; sum += e; }
    sum += __shfl_xor(sum, 32);
    const float inv = sum > 0.f ? 1.0f / sum : 0.f;
#pragma unroll
    for (int kt = 0; kt < 4; ++kt) S[kt] = S[kt] * inv;
    { LAS float* ip = IMP + (wave * 32 + r31) * 33; float carry = 0.f;
#pragma unroll
      for (int kt = 0; kt < 4; ++kt) { float a[4], pc[4];
#pragma unroll
          for (int rho = 0; rho < 4; ++rho) { a[rho] = (S[kt][4 * rho] + S[kt][4 * rho + 1]) + (S[kt][4 * rho + 2] + 0.5f * S[kt][4 * rho + 3]); pc[rho] = __shfl_xor(0.5f * S[kt][4 * rho + 3], 32); }
#pragma unroll
          for (int rho = 0; rho < 4; ++rho) { const float prev0 = (rho > 0) ? pc[rho > 0 ? rho - 1 : 0] : carry;
              ip[8 * kt + 2 * rho + hh] = a[rho] + (hh ? pc[rho] : prev0); }
          carry = pc[3]; } }
    f32x16 O[4];
#pragma unroll
    for (int dt = 0; dt < 4; ++dt) O[dt] = zero16();
#pragma unroll
    for (int kt = 0; kt < 4; ++kt)
#pragma unroll
        for (int s = 0; s < 2; ++s) pv_step(O, Vc, 32 * kt + 16 * s, pack8(S[kt], s), lane);
    { bf16_t* op = (bf16_t*)(C.ws + WS_OCMP) + (size_t)(b * T + tok) * 2048 + head * 128 + 4 * hh;
#pragma unroll
      for (int dt = 0; dt < 4; ++dt)
#pragma unroll
          for (int rho = 0; rho < 4; ++rho) { u32x2 w; w.x = pk2(O[dt][4 * rho], O[dt][4 * rho + 1]); w.y = pk2(O[dt][4 * rho + 2], O[dt][4 * rho + 3]); *(u32x2*)(op + 32 * dt + 8 * rho) = w; } }
    __syncthreads();
    if (tid < 64) { const int q = tid & 31, w0 = tid >> 5; unsigned mask;
        if (it < 16) mask = (2u << it) - 1u;
        else { float imp[32];
#pragma unroll
            for (int j = 0; j < 32; ++j) imp[j] = (IMP[((0 + w0) * 32 + q) * 33 + j] + IMP[((2 + w0) * 32 + q) * 33 + j]) + (IMP[((4 + w0) * 32 + q) * 33 + j] + IMP[((6 + w0) * 32 + q) * 33 + j]);
            mask = 1u | (1u << it) | (1u << (it - 1));
#pragma unroll
            for (int j = 1; j < 30; ++j) { if (j <= it - 2) { int rank = 0;
#pragma unroll
                    for (int k = 1; k < 30; ++k) { if (k <= it - 2) rank += (imp[k] > imp[j] || (imp[k] == imp[j] && k < j)) ? 1 : 0; }
                    if (rank < 13) mask |= (1u << j); } } }
        ((unsigned*)(C.ws + WS_SEL))[bg * T + t0 + tid] = mask; }
    __syncthreads();
}
template <int MODE>
DI void attn_tile(f32x16 (&O)[4], float& m, float& lsum, const bf16x8 (&Qf)[8], const LAS bf16_t* Kt, const LAS bf16_t* Vt, int kpos0, int tok, bool selbit, bool edge, int lane) {
    const int r31 = lane & 31, hh = lane >> 5;
    f32x16 S[2];
    { bf16x8 kf0[8], kf1[8];
      const LAS bf16_t* kb = Kt + r31 * KP + 8 * hh;
#pragma unroll
      for (int ks = 0; ks < 8; ++ks) kf0[ks] = *(const LAS bf16x8*)(kb + 16 * ks);
      __builtin_amdgcn_sched_barrier(0);
#pragma unroll
      for (int ks = 0; ks < 8; ++ks) kf1[ks] = *(const LAS bf16x8*)(kb + 32 * KP + 16 * ks);
      S[0] = zero16(); S[1] = zero16();
      __builtin_amdgcn_sched_barrier(0);
#pragma unroll
      for (int ks = 0; ks < 8; ++ks) S[0] = mfma32(kf0[ks], Qf[ks], S[0]);
      __builtin_amdgcn_sched_barrier(0);
#pragma unroll
      for (int ks = 0; ks < 8; ++ks) S[1] = mfma32(kf1[ks], Qf[ks], S[1]); }
    if (edge) {
#pragma unroll
        for (int kt = 0; kt < 2; ++kt)
#pragma unroll
            for (int r = 0; r < 16; ++r) { const int kp = kpos0 + 32 * kt + (r & 3) + 8 * (r >> 2) + 4 * hh;
                const bool ok = (MODE == 0) ? (kp <= tok) : (kp <= tok && kp > tok - 512);
                S[kt][r] = ok ? S[kt][r] : -INFINITY; } }
    float mx = -INFINITY;
#pragma unroll
    for (int kt = 0; kt < 2; ++kt)
#pragma unroll
        for (int r = 0; r < 16; ++r) mx = fmaxf(mx, S[kt][r]);
    mx = fmaxf(mx, __shfl_xor(mx, 32)) * ATT_C2;
    const bool rowon = (MODE != 0) || selbit;
    if (!rowon) mx = -INFINITY;
    if (__any(mx > m + 8.0f)) {
        const float mn = fmaxf(m, mx), alpha = __builtin_amdgcn_exp2f(m - mn);
        lsum *= alpha; m = mn;
#pragma unroll
        for (int dt = 0; dt < 4; ++dt) O[dt] = O[dt] * alpha; }
    const float mref = rowon ? m : INFINITY;
    float rs = 0.f;
#pragma unroll
    for (int kt = 0; kt < 2; ++kt)
#pragma unroll
        for (int r = 0; r < 16; ++r) { const float p = __builtin_amdgcn_exp2f(__builtin_fmaf(S[kt][r], ATT_C2, -mref)); S[kt][r] = p; rs += p; }
    rs += __shfl_xor(rs, 32);
    lsum += rs;
    { const int blk = (lane >> 4) & 1, q4 = (lane & 15) >> 2, p4 = lane & 3;
      const LAS bf16_t* vb = Vt + (4 * hh + q4) * VP + 16 * blk + 4 * p4;
      s16x4 va[8], vbf[8];
#define PV_LOAD(dst, st) do { _Pragma("unroll") for (int dt = 0; dt < 4; ++dt) { dst[2 * dt] = tr_read(vb + (16 * (st)) * VP + 32 * dt); dst[2 * dt + 1] = tr_read(vb + (16 * (st) + 8) * VP + 32 * dt); } } while (0)
#define PV_MMA(src, pf) do { _Pragma("unroll") for (int dt = 0; dt < 4; ++dt) O[dt] = mfma32(__builtin_shufflevector(src[2 * dt], src[2 * dt + 1], 0, 1, 2, 3, 4, 5, 6, 7), pf, O[dt]); } while (0)
      PV_LOAD(va, 0);
      const bf16x8 p0 = pack8(S[0], 0), p1 = pack8(S[0], 1), p2 = pack8(S[1], 0), p3 = pack8(S[1], 1);
      PV_LOAD(vbf, 1); PV_MMA(va, p0);
      PV_LOAD(va, 2);  PV_MMA(vbf, p1);
      PV_LOAD(vbf, 3); PV_MMA(va, p2);
      PV_MMA(vbf, p3);
#undef PV_LOAD
#undef PV_MMA
    }
}
DI void kv_load(u32x4 (&kr)[2], u32x4 (&vr)[2], const bf16_t* kg, const bf16_t* vg, int tid) {
#pragma unroll
    for (int k = 0; k < 2; ++k) { const int piece = tid + 512 * k, key = piece >> 4, ch = piece & 15;
        kr[k] = *(const u32x4*)(kg + (size_t)key * LDY + ch * 8); vr[k] = *(const u32x4*)(vg + (size_t)key * LDY + ch * 8); }
}
DI void kv_store(const u32x4 (&kr)[2], const u32x4 (&vr)[2], LAS bf16_t* Kt, LAS bf16_t* Vt, int tid) {
#pragma unroll
    for (int k = 0; k < 2; ++k) { const int piece = tid + 512 * k, key = piece >> 4, ch = piece & 15;
        *(LAS u32x4*)(Kt + key * KP + ch * 8) = kr[k]; *(LAS u32x4*)(Vt + key * VP + ch * 8) = vr[k]; }
}
DI void slc_win_unit(const Ctx& C, int bg, int it) {
    const int tid = C.tid, lane = C.lane, wave = C.wave, r31 = lane & 31, hh = lane >> 5;
    const int b = bg >> 2, g = bg & 3, t0 = 64 * it;
    LAS bf16_t* Kb0 = (LAS bf16_t*)C.lds; LAS bf16_t* Kb1 = Kb0 + 64 * KP; LAS bf16_t* Vb0 = Kb1 + 64 * KP; LAS bf16_t* Vb1 = Vb0 + 64 * VP;
    LAS unsigned* uni = (LAS unsigned*)(Vb1 + 64 * VP);
    const bf16_t* Ybf = (const bf16_t*)(C.ws + WS_YBF); const float* Yf = (const float*)(C.ws + WS_YF);
    const int head = 4 * g + (wave >> 1), tq = 32 * (wave & 1), tok = t0 + tq + r31; const size_t row = (size_t)(b * T + tok);
    const unsigned sel = ((const unsigned*)(C.ws + WS_SEL))[bg * T + tok];
    if (wave < 2) { unsigned u = sel;
#pragma unroll
        for (int o = 1; o < 32; o <<= 1) u |= __shfl_xor(u, o);
        if (lane == 0) uni[wave] = u; }
    bf16x8 Qf[8];
    { const bf16_t* qp = Ybf + row * LDY + Y_NQ + head * 128 + 8 * hh;
#pragma unroll
      for (int ks = 0; ks < 8; ++ks) Qf[ks] = *(const bf16x8*)(qp + 16 * ks); }
    rope_q(Qf, (const float*)(C.ws + WS_ROPE_C), (const float*)(C.ws + WS_ROPE_S), tok, hh);
    __syncthreads();
    unsigned umask = __builtin_amdgcn_readfirstlane(uni[0] | uni[1]);
    const bf16_t* kbase = Ybf + (size_t)(b * T) * LDY + Y_KS + g * 128; const bf16_t* vbase = Ybf + (size_t)(b * T) * LDY + Y_VS + g * 128;
    f32x16 O[4]; float m = -1e30f, lsum = 0.f;
#pragma unroll
    for (int dt = 0; dt < 4; ++dt) O[dt] = zero16();
    u32x4 kr[2], vr[2];
    { int j = __builtin_ctz(umask); umask &= umask - 1u;
      kv_load(kr, vr, kbase + (size_t)(64 * j) * LDY, vbase + (size_t)(64 * j) * LDY, tid); kv_store(kr, vr, Kb0, Vb0, tid);
      __syncthreads();
      int par = 0;
      for (;;) { const bool more = umask != 0u; int jn = 0;
          if (more) { jn = __builtin_ctz(umask); umask &= umask - 1u; kv_load(kr, vr, kbase + (size_t)(64 * jn) * LDY, vbase + (size_t)(64 * jn) * LDY, tid); }
          attn_tile<0>(O, m, lsum, Qf, par ? Kb1 : Kb0, par ? Vb1 : Vb0, 64 * j, tok, ((sel >> j) & 1u) != 0u, j == it, lane);
          if (!more) break;
          kv_store(kr, vr, par ? Kb0 : Kb1, par ? Vb0 : Vb1, tid);
          __syncthreads();
          par ^= 1; j = jn; } }
    const float inv1 = 1.0f / lsum;
    LAS bf16_t* osl = (LAS bf16_t*)(C.lds + 76800) + (wave * 32 + r31) * 136 + 4 * hh;
#pragma unroll
    for (int dt = 0; dt < 4; ++dt)
#pragma unroll
        for (int rho = 0; rho < 4; ++rho) { u32x2 w; w.x = pk2(O[dt][4 * rho] * inv1, O[dt][4 * rho + 1] * inv1); w.y = pk2(O[dt][4 * rho + 2] * inv1, O[dt][4 * rho + 3] * inv1); *(LAS u32x2*)(osl + 32 * dt + 8 * rho) = w; }
    m = -1e30f; lsum = 0.f;
#pragma unroll
    for (int dt = 0; dt < 4; ++dt) O[dt] = zero16();
    __syncthreads();
    { int j = it > 8 ? it - 8 : 0;
      kv_load(kr, vr, kbase + (size_t)(64 * j) * LDY + (Y_KW - Y_KS), vbase + (size_t)(64 * j) * LDY + (Y_VW - Y_VS), tid); kv_store(kr, vr, Kb0, Vb0, tid);
      __syncthreads();
      int par = 0;
      for (;;) { const bool more = j < it;
          if (more) kv_load(kr, vr, kbase + (size_t)(64 * (j + 1)) * LDY + (Y_KW - Y_KS), vbase + (size_t)(64 * (j + 1)) * LDY + (Y_VW - Y_VS), tid);
          attn_tile<1>(O, m, lsum, Qf, par ? Kb1 : Kb0, par ? Vb1 : Vb0, 64 * j, tok, true, (j == it) || (j == it - 8), lane);
          if (!more) break;
          kv_store(kr, vr, par ? Kb0 : Kb1, par ? Vb0 : Vb1, tid);
          __syncthreads();
          par ^= 1; ++j; } }
    const float inv2 = 1.0f / lsum;
    const float* gp = Yf + row * LDF + F_GATE + head * 3;
    const float g0 = sigmoid_f(gp[0]), g1 = sigmoid_f(gp[1]), g2 = sigmoid_f(gp[2]) * inv2;
    const bf16_t* ocp = (const bf16_t*)(C.ws + WS_OCMP) + row * 2048 + head * 128 + 4 * hh;
    bf16_t* mx = (bf16_t*)(C.ws + WS_MIX) + row * DM + 2048 + head * 128 + 4 * hh;
#pragma unroll
    for (int dt = 0; dt < 4; ++dt)
#pragma unroll
        for (int rho = 0; rho < 4; ++rho) { const u32x2 ocw = *(const u32x2*)(ocp + 32 * dt + 8 * rho), osw = *(const LAS u32x2*)(osl + 32 * dt + 8 * rho);
            const f32x4 oc = {bflo(ocw.x), bfhi(ocw.x), bflo(ocw.y), bfhi(ocw.y)}, os = {bflo(osw.x), bfhi(osw.x), bflo(osw.y), bfhi(osw.y)};
            u32x2 w; w.x = pk2(g0 * oc[0] + g1 * os[0] + g2 * O[dt][4 * rho], g0 * oc[1] + g1 * os[1] + g2 * O[dt][4 * rho + 1]);
            w.y = pk2(g0 * oc[2] + g1 * os[2] + g2 * O[dt][4 * rho + 2], g0 * oc[3] + g1 * os[3] + g2 * O[dt][4 * rho + 3]);
            *(u32x2*)(mx + 32 * dt + 8 * rho) = w; }
    __syncthreads();
}
}

#ifndef MK_N_LAUNCHES
#define MK_N_LAUNCHES 1
#endif
constexpr int PH_PER_LAYER = 10, N_PHASES = 2 + hy::DEPTH * PH_PER_LAYER;
struct Args { const float* in[hy::N_INPUTS]; float* out; unsigned char* ws; int ph_lo, ph_hi; };
static_assert(sizeof(Args) == hy::N_INPUTS * 8 + 24, "Args has padding");

__global__ void __launch_bounds__(512, 2) hy_fwd(Args args) {
    using namespace hy;
    extern __shared__ __attribute__((aligned(16))) unsigned char lds_raw[];
    Ctx C0;
    { Ctx& C = C0;
    C.lds = (LAS unsigned char*)lds_raw;
    C.tid = threadIdx.x; C.lane = C.tid & 63; C.wave = __builtin_amdgcn_readfirstlane(C.tid >> 6);
    C.G = gridDim.x; { const int bx = blockIdx.x; C.vcu = (C.G % 8 == 0) ? (bx % 8) * (C.G / 8) + bx / 8 : bx; }
    C.kin = (const float* const __attribute__((address_space(4)))*)__builtin_amdgcn_kernarg_segment_ptr();
    C.out = (GAS float*)args.out; C.ws = (GAS unsigned char*)args.ws; }
    const Ctx& C = C0;
    volatile LAS unsigned* MISC = (volatile LAS unsigned*)(C.lds + MISC_OFF);
    if (C.tid < 64) MISC[C.tid] = 0u;
    __syncthreads();
    const int lo = args.ph_lo, hi = args.ph_hi;
    unsigned* ctl = (unsigned*)(C.ws + WS_CTL);
    XcdBarrier bar; bar.bar = ctl + CW_BAR; bar.x = 0; bar.st = MISC + 8;
    if (hi - lo > 1) { bar = xcd_barrier_post(ctl + CW_BAR, MISC + 8); bar.wv = C.wave; }
    int ph = 0;
#ifndef P4_SEL
#define P4_SEL 3
#endif
#ifndef P0_MODE
#define P0_MODE 0
#endif
#ifndef P0_REPS
#define P0_REPS 1
#endif
#ifndef BAR_REPS
#define BAR_REPS 1
#endif
#ifndef P3R_REPS
#define P3R_REPS 1
#endif
#ifndef P3H_REPS
#define P3H_REPS 1
#endif
#ifndef P3G_REPS
#define P3G_REPS 1
#endif
#ifndef P3_SEL
#define P3_SEL 7
#endif
#ifndef PH_MASK
#define PH_MASK 0xFFFFFFFFu
#endif
#define PH_EN(k) (((PH_MASK) >> (k)) & 1u)
#ifndef PH_REPM
#define PH_REPM 0x0u
#endif
#define PH_REP(k) (((PH_REPM) >> (k)) & 1u)
#define PHASE(k, ...) PH_BEGIN if (PH_EN(k)) { __VA_ARGS__ } if (PH_REP(k)) { { XcdBarrier bq = bar; GAS unsigned* gb_ = (GAS unsigned*)bar.bar; asm volatile("" : "+s"(gb_), "+s"(bq.x)); bq.bar = (unsigned*)gb_; xcd_barrier(bq); } __VA_ARGS__ } PH_END
#define PH_BEGIN if (ph >= lo && ph < hi) { Ctx P = C0; asm volatile("" : "+s"(P.ws), "+s"(P.kin), "+s"(P.wave), "+s"(P.vcu), "+s"(P.G)); P.lane = lane_id_fresh(); P.tid = P.wave * 64 + P.lane; const Ctx& C = P;
#define PH_END if (ph + 1 < hi) { XcdBarrier bq = bar; GAS unsigned* gb_ = (GAS unsigned*)bar.bar; asm volatile("" : "+s"(gb_), "+s"(bq.x)); bq.bar = (unsigned*)gb_; _Pragma("nounroll") for (int rep_ = 0; rep_ < BAR_REPS; ++rep_) xcd_barrier(bq); } } ++ph;

    PHASE(13, phase_tables(C);)
#define Hb ((bf16_t*)(C.ws + WS_H))
#define Ybf ((bf16_t*)(C.ws + WS_YBF))
#define Yf ((float*)(C.ws + WS_YF))
#define XA ((float*)(C.ws + WS_XA))
#define Hb1 ((bf16_t*)(C.ws + WS_XA))
#define XB ((float*)(C.ws + WS_XB))
#define ACT ((bf16_t*)(C.ws + WS_ACT))
#define MIX ((bf16_t*)(C.ws + WS_MIX))
#define xin ((l == 0) ? C.kin[IN_X] : (const float*)XB)
    for (int l = 0; l < DEPTH; ++l) {
        PHASE(0, _Pragma("nounroll") for (int rep = 1; rep < P0_REPS; ++rep) { phase_p0_t<P0_MODE>(C, l); __syncthreads(); } phase_p0(C, l); __syncthreads(); if (l == 0) phase_xcvt(C, C.kin[IN_X], Hb, (unsigned long long*)(C.ws + WS_RSB));)
        PHASE(2, { constexpr int GC = 256 - P0_NDED, rem = ((M / 256) * (NINP / 256)) % GC;
            if (C.G == 256 && (int)blockIdx.x >= GC) p0_fill_in_ded(C, l, (int)blockIdx.x - GC, P0_NDED);
            else { pg8::Gemm g{Hb, (const bf16_t*)(C.ws + WS_WIN_L(l)), M, NINP, DM}; pg8::StaticOrder S; S.init(M, NINP, (C.G == 256) ? GC : C.G, (int)blockIdx.x);
                pg8::EpiIn E{Ybf, Yf, LDY, LDF, NBF_TILES, (const unsigned long long*)(C.ws + WS_RSB), 1.0f / DM, NORM_EPS}; pg8::gemm_phase<pg8::EpiIn, pg8::StaticOrder, true, true>(C.lds, g, S, E, C.wave);
                if (C.G == 256 && rem && (int)blockIdx.x >= rem) { __syncthreads(); p0_fill_in_tail(C, l, (int)blockIdx.x - rem, GC - rem); } } })
        PHASE(3, if (P3_SEL & 1) phase_rope(C); _Pragma("nounroll") for (int rep = 1; rep < P3R_REPS; ++rep) { __syncthreads(); phase_rope(C, -1.0f); __syncthreads(); phase_rope(C, 1.0f); }
            _Pragma("nounroll") for (int rep = 0; rep < P3H_REPS; ++rep) for (int u = C.vcu; u < NUNIT; u += C.G) hgrn_pre_unit(C, l, u);
            _Pragma("nounroll") for (int rep = 0; rep < P3G_REPS; ++rep) for (int u = C.vcu; u < NUNIT; u += C.G) gdn_pre_unit(C, l, u);)
        PHASE(4, if (P4_SEL & 1) { pg8::Gemm g{(const bf16_t*)(C.ws + WS_KCV), (const bf16_t*)(C.ws + WS_W1CAT), 4096, 1024, 512, 2048, 2048}; pg8::CmpOrder S{C.G, (int)blockIdx.x};
            pg8::EpiRes E{(bf16_t*)(C.ws + WS_PQ), 1024, (size_t)4096 * 1024}; pg8::gemm_phase<pg8::EpiRes, pg8::CmpOrder, false, true>(C.lds, g, S, E, C.wave); }
            __syncthreads();
            if (P4_SEL & 2) for (int su = C.vcu; su < 256; su += C.G) scan_unit(C, su);)
        PHASE(5, for (int e = C.vcu; e < 256; e += C.G) cmp_mlp2_unit(C, l, e);
            phase_finalize_ab(C, l);)
        PHASE(6, for (int f = C.vcu; f < 512; f += C.G) cmp_attn_unit(C, f);)
        PHASE(7, for (int k = C.vcu; k < 512; k += C.G) { const int kk = k & 255, bg = kk >> 4, ii = kk & 15; slc_win_unit(C, bg, (k < 256) ? ii : 31 - ii); })
        PHASE(8, { pg8::Gemm g{MIX, (const bf16_t*)(C.ws + WS_WOUT), M, DM, DM}; pg8::StaticOrder S; S.init(M, DM, C.G, (int)blockIdx.x);
            pg8::EpiResNorm E{(l == 0) ? C.kin[IN_X] : (const float*)nullptr, Hb, Hb1, (unsigned long long*)(C.ws + WS_RSA), DM}; pg8::gemm_phase<pg8::EpiResNorm, pg8::StaticOrder, true, true>(C.lds, g, S, E, C.wave); })
        PHASE(10, { pg8::Gemm g{Hb1, (const bf16_t*)(C.ws + WS_WGU), M, 2 * FF, DM}; pg8::StaticOrder S; S.init(M, 2 * FF, C.G, (int)blockIdx.x);
            pg8::EpiSwiGLU E{ACT, FF, (const unsigned long long*)(C.ws + WS_RSA), 1.0f / DM, NORM_EPS}; pg8::gemm_phase<pg8::EpiSwiGLU, pg8::StaticOrder, true, true>(C.lds, g, S, E, C.wave); }
            if (C.G == 256) { constexpr int rem = ((M / 256) * (2 * FF / 256)) % 256; if (rem && (int)blockIdx.x >= rem) { __syncthreads(); p0_fill_wdown(C, l, (int)blockIdx.x - rem, 256 - rem); } })
        PHASE(11, { pg8::Gemm g{ACT, (const bf16_t*)(C.ws + WS_WD), M, DM, FF}; pg8::StaticOrder S; S.init(M, DM, C.G, (int)blockIdx.x);
            pg8::EpiResNorm E{nullptr, Hb1, Hb, (unsigned long long*)(C.ws + WS_RSB), DM}; pg8::gemm_phase<pg8::EpiResNorm, pg8::StaticOrder, true, true>(C.lds, g, S, E, C.wave); })
    }
    PHASE(12, phase_final_norm(C, Hb, C.kin[IN_FINAL_NORM], (float*)C.out);)
#undef PH_BEGIN
#undef Hb
#undef Ybf
#undef Yf
#undef XA
#undef Hb1
#undef XB
#undef ACT
#undef MIX
#undef xin
#undef PH_END
}

extern "C" void kernel_launch(void* const* d_in, const int* in_sizes, int n_in, void* d_out, int out_size, void* d_ws, size_t ws_size, hipStream_t stream) {
    static int grid = 0;
    if (grid == 0) {
        if (n_in != hy::N_INPUTS || in_sizes[0] != hy::M * hy::DM || out_size != hy::M * hy::DM || ws_size < hy::WS_END) {
            fprintf(stderr, "kernel_launch: built for %d inputs, x/out of %d floats, >= %zu bytes of workspace; got n_in %d, in0 %d, out %d, ws %zu; nothing launched\n", hy::N_INPUTS, hy::M * hy::DM, (size_t)hy::WS_END, n_in, n_in > 0 ? in_sizes[0] : -1, out_size, ws_size); grid = -1; return; }
        int dev = 0, cus = 0, per_cu = 0;
        if (hipGetDevice(&dev) != hipSuccess || hipDeviceGetAttribute(&cus, hipDeviceAttributeMultiprocessorCount, dev) != hipSuccess) { fprintf(stderr, "kernel_launch: device query failed\n"); grid = -1; return; }
        if (hipFuncSetAttribute((const void*)hy_fwd, hipFuncAttributeMaxDynamicSharedMemorySize, hy::LDS_BYTES) != hipSuccess) { fprintf(stderr, "kernel_launch: hipFuncSetAttribute failed\n"); grid = -1; return; }
        if (hipOccupancyMaxActiveBlocksPerMultiprocessor(&per_cu, (const void*)hy_fwd, 512, hy::LDS_BYTES) != hipSuccess || per_cu < 1)
            fprintf(stderr, "kernel_launch: note: occupancy query reports %d workgroups per CU\n", per_cu);
        (void)hipGetLastError();
        grid = cus;
    }
    if (grid < 0) return;
    if (hipMemsetAsync((char*)d_ws + hy::WS_CTL, 0, hy::CTL_BYTES, stream) != hipSuccess) { fprintf(stderr, "kernel_launch: memset failed\n"); return; }
    Args a{};
    for (int i = 0; i < hy::N_INPUTS; ++i) a.in[i] = (const float*)d_in[i];
    a.out = (float*)d_out; a.ws = (unsigned char*)d_ws;
#if MK_N_LAUNCHES == 1
    a.ph_lo = 0; a.ph_hi = N_PHASES;
    hipLaunchKernelGGL(hy_fwd, dim3(grid), dim3(512), hy::LDS_BYTES, stream, a);
#else
    for (int p = 0; p < N_PHASES; ++p) { a.ph_lo = p; a.ph_hi = p + 1; hipLaunchKernelGGL(hy_fwd, dim3(grid), dim3(512), hy::LDS_BYTES, stream, a); }
#endif
    const hipError_t le = hipPeekAtLastError();
    if (le != hipSuccess) fprintf(stderr, "kernel_launch: launch failed: %s\n", hipGetErrorName(le));
}
```
